# Optimizing an MI355X kernel written in HIP

```python
import jax, jax.numpy as jnp
from jax import lax
import numpy as np

D_MODEL = 2048
BATCH = 16
SEQ = 256
DEPTH = 2
DEC_BATCH = 8
DEC_SEQ = 4096
PAST_LEN = 256

GRID_W = 64
N_EVEN = (DEPTH + 1) // 2
N_ODD = DEPTH // 2
ALPHA = (2 * DEPTH) ** 0.25
LN_EPS = 1e-5
RMS_EPS = 1e-6
Q_BLOCK = 128
N_MOD = 9
D_FF = 5632
NA_HEADS = 8
NA_HEAD_DIM = 128
NA_WIDTH = NA_HEADS * NA_HEAD_DIM
NA_ROWS = 8
NA_COLS = 16
POOL_WINDOWS = (2, 4, 8, 16)
POOL_GROUPS = 4
POOL_CH = D_MODEL // 8
POOL_WIDTH = POOL_GROUPS * POOL_CH
MIX0_IN = 3 * NA_WIDTH + POOL_WIDTH
MIX0_OUT = NA_WIDTH + POOL_WIDTH
MLA_HEADS = 16
Q_LORA = 512
KV_LORA = 512
QK_NOPE = 128
QK_ROPE = 64
V_DIM = 128
MLA_DOWN = Q_LORA + KV_LORA + QK_ROPE
ROPE_AXIS = QK_ROPE // 2
ROPE_BASE = 10000.0

kernel_name = 'hybrid_diffusion_na_pool_mla_step'


def layer_norm(x, g, b):
    xf = x.astype(jnp.float32)
    mu = jnp.mean(xf, axis=-1, keepdims=True)
    var = jnp.mean(jnp.square(xf - mu), axis=-1, keepdims=True)
    y = (xf - mu) * lax.rsqrt(var + LN_EPS) * g.astype(jnp.float32) + b.astype(jnp.float32)
    return y.astype(x.dtype)


def rms_norm(x, g):
    xf = x.astype(jnp.float32)
    y = xf * lax.rsqrt(jnp.mean(jnp.square(xf), axis=-1, keepdims=True) + RMS_EPS) * g.astype(jnp.float32)
    return y.astype(x.dtype)


def swiglu(h, w1, w3, w2):
    return (jax.nn.silu(h @ w1) * (h @ w3)) @ w2


def modulate(x, mod, j):
    shift = mod[:, None, 3 * j]
    scale = mod[:, None, 3 * j + 1]
    gate = mod[:, None, 3 * j + 2]
    return x * (1 + scale) + shift, gate


def post_norm(x, update, g, b):
    return layer_norm(ALPHA * x + update, g, b)


def dense_attention(q, k, v, scale):
    B_, Lq, H, Dq = q.shape
    nb = Lq // Q_BLOCK
    qb = q.reshape(B_, nb, Q_BLOCK, H, Dq).transpose(1, 0, 2, 3, 4)

    def block(qi):
        s = jnp.einsum('bqhd,bkhd->bhqk', qi, k).astype(jnp.float32) * scale
        p = jax.nn.softmax(s, axis=-1).astype(v.dtype)
        return jnp.einsum('bhqk,bkhd->bqhd', p, v)

    o = lax.map(block, qb)
    return o.transpose(1, 0, 2, 3, 4).reshape(B_, Lq, H, v.shape[-1])


def axial_rope_angles(n_tokens):
    t = jnp.arange(n_tokens)
    inv = ROPE_BASE ** (-jnp.arange(0, ROPE_AXIS, 2, dtype=jnp.float32) / ROPE_AXIS)
    ang_row = (t // GRID_W).astype(jnp.float32)[:, None] * inv[None, :]
    ang_col = (t % GRID_W).astype(jnp.float32)[:, None] * inv[None, :]
    return ang_row, ang_col


def _rotate(x, ang):
    x1, x2 = jnp.split(x, 2, axis=-1)
    cos, sin = jnp.cos(ang), jnp.sin(ang)
    return jnp.concatenate([x1 * cos - x2 * sin, x2 * cos + x1 * sin], axis=-1)


def axial_rope(x, ang_row, ang_col):
    bshape = (x.shape[1],) + (1,) * (x.ndim - 3) + (ang_row.shape[-1],)
    xr, xc = jnp.split(x.astype(jnp.float32), 2, axis=-1)
    out = jnp.concatenate([_rotate(xr, ang_row.reshape(bshape)),
                           _rotate(xc, ang_col.reshape(bshape))], axis=-1)
    return out.astype(x.dtype)


def multiscale_pool(u, w_pool, pool_scale):
    B_, L, _ = u.shape
    ug = u.reshape(B_, L, POOL_GROUPS, POOL_CH)
    cs = jnp.cumsum(ug.astype(jnp.float32), axis=1)
    cs = jnp.concatenate([jnp.zeros_like(cs[:, :1]), cs], axis=1)
    t = jnp.arange(L)
    means = []
    for g, w in enumerate(POOL_WINDOWS):
        lo = jnp.clip(t - w // 2, 0, L)
        hi = jnp.clip(t + w // 2, 0, L)
        csg = cs[:, :, g]
        s = jnp.take(csg, hi, axis=1) - jnp.take(csg, lo, axis=1)
        means.append(s / (hi - lo).astype(jnp.float32)[None, :, None])
    pooled = jnp.stack(means, axis=2)
    d = (pooled - ug.astype(jnp.float32)).astype(u.dtype)
    y = jnp.einsum('blgc,gcd->blgd', d, w_pool).reshape(B_, L, POOL_WIDTH)
    return y * pool_scale


def neighbourhood_attention(q, k, v, k_ctx, v_ctx, rpb):
    B_, L, H, Dh = q.shape
    rows = L // GRID_W
    kr = min(NA_ROWS, rows)
    kc = NA_COLS
    scale = Dh ** -0.5
    col = jnp.arange(GRID_W)
    col_start = jnp.clip(col - kc // 2, 0, GRID_W - kc)
    col_idx = col_start[:, None] + jnp.arange(kc)[None, :]
    dc = col_idx - col[:, None]
    kg = k.reshape(B_, rows, GRID_W, H, Dh)
    vg = v.reshape(B_, rows, GRID_W, H, Dh)
    q_rows = q.reshape(B_, rows, GRID_W, H, Dh).transpose(1, 0, 2, 3, 4)

    def row_block(args):
        r, qb = args
        rs = jnp.clip(r - kr // 2, 0, rows - kr)
        kb = lax.dynamic_slice_in_dim(kg, rs, kr, axis=1)
        vb = lax.dynamic_slice_in_dim(vg, rs, kr, axis=1)
        kq = kb[:, :, col_idx]
        vq = vb[:, :, col_idx]
        dr = rs + jnp.arange(kr) - r
        bias = rpb[:, dr[:, None, None] + NA_ROWS - 1, dc[None] + NA_COLS - 1]
        bias = bias.transpose(0, 2, 1, 3).reshape(H, GRID_W, kr * kc).astype(jnp.float32)
        s_loc = jnp.einsum('bqhd,biqjhd->bhqij', qb, kq).astype(jnp.float32)
        s_loc = s_loc.reshape(B_, H, GRID_W, kr * kc) * scale + bias[None]
        s_ctx = jnp.einsum('bqhd,bkhd->bhqk', qb, k_ctx).astype(jnp.float32) * scale
        p = jax.nn.softmax(jnp.concatenate([s_loc, s_ctx], axis=-1), axis=-1).astype(v.dtype)
        p_loc = p[..., :kr * kc].reshape(B_, H, GRID_W, kr, kc)
        p_ctx = p[..., kr * kc:]
        return (jnp.einsum('bhqij,biqjhd->bqhd', p_loc, vq)
                + jnp.einsum('bhqk,bkhd->bqhd', p_ctx, v_ctx))

    o = lax.map(row_block, (jnp.arange(rows), q_rows))
    return o.transpose(1, 0, 2, 3, 4).reshape(B_, L, H, Dh)


def even_mixer(h, ctx, w_in, w_out, rpb, w_pool, pool_scale):
    B_, L, _ = h.shape
    proj = h @ w_in
    q = proj[..., :NA_WIDTH].reshape(B_, L, NA_HEADS, NA_HEAD_DIM)
    k = proj[..., NA_WIDTH:2 * NA_WIDTH].reshape(B_, L, NA_HEADS, NA_HEAD_DIM)
    v = proj[..., 2 * NA_WIDTH:3 * NA_WIDTH].reshape(B_, L, NA_HEADS, NA_HEAD_DIM)
    u = proj[..., 3 * NA_WIDTH:]
    if ctx is None:
        a = dense_attention(q, k, v, NA_HEAD_DIM ** -0.5)
        st = (k, v)
    else:
        a = neighbourhood_attention(q, k, v, ctx[0], ctx[1], rpb)
        st = None
    pooled = multiscale_pool(u, w_pool, pool_scale)
    y = jnp.concatenate([a.reshape(B_, L, NA_WIDTH), pooled], axis=-1) @ w_out
    return y, st


def mla_expand(ckv, kpe, w_ukv):
    B_, L, _ = ckv.shape
    kv = (ckv @ w_ukv).reshape(B_, L, MLA_HEADS, QK_NOPE + V_DIM)
    k_pe = jnp.broadcast_to(kpe[:, :, None, :], (B_, L, MLA_HEADS, QK_ROPE))
    k = jnp.concatenate([kv[..., :QK_NOPE], k_pe], axis=-1)
    return k, kv[..., QK_NOPE:]


def odd_mixer(h, ctx, w_down, q_norm, w_uq, kv_norm, w_ukv, w_out):
    B_, L, _ = h.shape
    down = h @ w_down
    cq = rms_norm(down[..., :Q_LORA], q_norm)
    ckv = rms_norm(down[..., Q_LORA:Q_LORA + KV_LORA], kv_norm)
    kpe = down[..., Q_LORA + KV_LORA:]
    q = (cq @ w_uq).reshape(B_, L, MLA_HEADS, QK_NOPE + QK_ROPE)
    if ctx is None:
        k, v = mla_expand(ckv, kpe, w_ukv)
        st = (ckv, kpe)
    else:
        ang_r, ang_c = axial_rope_angles(L)
        q = jnp.concatenate([q[..., :QK_NOPE], axial_rope(q[..., QK_NOPE:], ang_r, ang_c)], axis=-1)
        k_lat, v_lat = mla_expand(ckv, axial_rope(kpe, ang_r, ang_c), w_ukv)
        k_ctx, v_ctx = mla_expand(ctx[0], ctx[1], w_ukv)
        k = jnp.concatenate([k_lat, k_ctx], axis=1)
        v = jnp.concatenate([v_lat, v_ctx], axis=1)
        st = None
    o = dense_attention(q, k, v, (QK_NOPE + QK_ROPE) ** -0.5)
    return o.reshape(B_, L, MLA_HEADS * V_DIM) @ w_out, st


def run_trunk(x, cond, caches, w_mod, b_mod, ln_g, ln_b, ffn_w1, ffn_w3, ffn_w2,
              na_w_in, mix0_w_out, na_rpb, pool_w, pool_scale,
              mla_w_down, mla_q_norm, mla_w_uq, mla_kv_norm, mla_w_ukv, mla_w_out):
    ctx_even, ctx_odd = [], []
    for l in range(DEPTH):
        mod = (jax.nn.silu(cond) @ w_mod[l] + b_mod[l]).reshape(cond.shape[0], N_MOD, D_MODEL)
        h, gate = modulate(x, mod, 0)
        x = post_norm(x, 0.5 * gate * swiglu(h, ffn_w1[l, 0], ffn_w3[l, 0], ffn_w2[l, 0]),
                      ln_g[l, 0], ln_b[l, 0])
        h, gate = modulate(x, mod, 1)
        i = l // 2
        if l % 2 == 0:
            ctx = None if caches is None else (caches[0][:, i], caches[1][:, i])
            y, st = even_mixer(h, ctx, na_w_in[i], mix0_w_out[i], na_rpb[i], pool_w[i], pool_scale[i])
            ctx_even.append(st)
        else:
            ctx = None if caches is None else (caches[2][:, i], caches[3][:, i])
            y, st = odd_mixer(h, ctx, mla_w_down[i], mla_q_norm[i], mla_w_uq[i],
                              mla_kv_norm[i], mla_w_ukv[i], mla_w_out[i])
            ctx_odd.append(st)
        x = post_norm(x, gate * y, ln_g[l, 1], ln_b[l, 1])
        h, gate = modulate(x, mod, 2)
        x = post_norm(x, 0.5 * gate * swiglu(h, ffn_w1[l, 1], ffn_w3[l, 1], ffn_w2[l, 1]),
                      ln_g[l, 2], ln_b[l, 2])
    return x, ctx_even, ctx_odd


def setup_inputs(seed: int = 0) -> dict:
    key = jax.random.key(seed)
    ks = iter(jax.random.split(key, 40))

    def nrm(shape, scale):
        return jax.random.normal(next(ks), shape, jnp.float32) * scale

    beta = (8 * DEPTH) ** -0.25
    D = D_MODEL
    return {
        'x_prompt': nrm((BATCH, SEQ, D), 1.0),
        'x_sample': nrm((DEC_BATCH, DEC_SEQ, D), 1.0),
        'cache_na_k': nrm((DEC_BATCH, N_EVEN, PAST_LEN, NA_HEADS, NA_HEAD_DIM), 1.0),
        'cache_na_v': nrm((DEC_BATCH, N_EVEN, PAST_LEN, NA_HEADS, NA_HEAD_DIM), 1.0),
        'cache_mla_ckv': nrm((DEC_BATCH, N_ODD, PAST_LEN, KV_LORA), 1.0),
        'cache_mla_kpe': nrm((DEC_BATCH, N_ODD, PAST_LEN, QK_ROPE), 1.0),
        'c': nrm((DEC_BATCH, D), 1.0),
        'c_ctx': nrm((D,), 1.0),
        'w_mod': nrm((DEPTH, D, N_MOD * D), 0.5 * D ** -0.5),
        'b_mod': nrm((DEPTH, N_MOD * D), 0.02),
        'ln_g': 1.0 + nrm((DEPTH, 3, D), 0.02),
        'ln_b': nrm((DEPTH, 3, D), 0.02),
        'ffn_w1': nrm((DEPTH, 2, D, D_FF), D ** -0.5),
        'ffn_w3': nrm((DEPTH, 2, D, D_FF), D ** -0.5),
        'ffn_w2': nrm((DEPTH, 2, D_FF, D), beta * D_FF ** -0.5),
        'na_w_in': nrm((N_EVEN, D, MIX0_IN), D ** -0.5),
        'mix0_w_out': nrm((N_EVEN, MIX0_OUT, D), beta * MIX0_OUT ** -0.5),
        'na_rpb': nrm((N_EVEN, NA_HEADS, 2 * NA_ROWS - 1, 2 * NA_COLS - 1), 0.1),
        'pool_w': nrm((N_EVEN, POOL_GROUPS, POOL_CH, POOL_CH), POOL_CH ** -0.5),
        'pool_scale': 1.0 + nrm((N_EVEN, POOL_WIDTH), 0.02),
        'mla_w_down': nrm((N_ODD, D, MLA_DOWN), D ** -0.5),
        'mla_q_norm': 1.0 + nrm((N_ODD, Q_LORA), 0.02),
        'mla_w_uq': nrm((N_ODD, Q_LORA, MLA_HEADS * (QK_NOPE + QK_ROPE)), Q_LORA ** -0.5),
        'mla_kv_norm': 1.0 + nrm((N_ODD, KV_LORA), 0.02),
        'mla_w_ukv': nrm((N_ODD, KV_LORA, MLA_HEADS * (QK_NOPE + V_DIM)), KV_LORA ** -0.5),
        'mla_w_out': nrm((N_ODD, MLA_HEADS * V_DIM, D), beta * (MLA_HEADS * V_DIM) ** -0.5),
    }


def reference(x_prompt, x_sample, cache_na_k, cache_na_v, cache_mla_ckv, cache_mla_kpe, c, c_ctx,
              w_mod, b_mod, ln_g, ln_b, ffn_w1, ffn_w3, ffn_w2,
              na_w_in, mix0_w_out, na_rpb, pool_w, pool_scale,
              mla_w_down, mla_q_norm, mla_w_uq, mla_kv_norm, mla_w_ukv, mla_w_out):
    y_prompt, ctx_even, ctx_odd = run_trunk(
        x_prompt, c_ctx[None, :], None, w_mod, b_mod, ln_g, ln_b, ffn_w1, ffn_w3, ffn_w2,
        na_w_in, mix0_w_out, na_rpb, pool_w, pool_scale,
        mla_w_down, mla_q_norm, mla_w_uq, mla_kv_norm, mla_w_ukv, mla_w_out)
    y_sample, _, _ = run_trunk(
        x_sample, c, (cache_na_k, cache_na_v, cache_mla_ckv, cache_mla_kpe),
        w_mod, b_mod, ln_g, ln_b, ffn_w1, ffn_w3, ffn_w2,
        na_w_in, mix0_w_out, na_rpb, pool_w, pool_scale,
        mla_w_down, mla_q_norm, mla_w_uq, mla_kv_norm, mla_w_ukv, mla_w_out)
    new_na_k = jnp.stack([s[0] for s in ctx_even], axis=1)
    new_na_v = jnp.stack([s[1] for s in ctx_even], axis=1)
    new_mla_ckv = jnp.stack([s[0] for s in ctx_odd], axis=1)
    new_mla_kpe = jnp.stack([s[1] for s in ctx_odd], axis=1)
    return (y_prompt, y_sample, new_na_k, new_na_v, new_mla_ckv, new_mla_kpe)
```

```cpp
#include <hip/hip_runtime.h>
#include <cstdio>
#include <cstdint>
__device__ __forceinline__ int hw_lane() { unsigned z = 0u; asm volatile("" : "+v"(z)); return (int)__builtin_amdgcn_mbcnt_hi(~0u, __builtin_amdgcn_mbcnt_lo(~0u, z)); }
template <int M> __device__ __forceinline__ float shfl_xor_c(float v) {
  static_assert(M == 1 || M == 2 || M == 4 || M == 8 || M == 16, "mask");
  if constexpr (M == 1) return __builtin_bit_cast(float, __builtin_amdgcn_mov_dpp(__builtin_bit_cast(int, v), 0xB1, 0xF, 0xF, true));
  else if constexpr (M == 2) return __builtin_bit_cast(float, __builtin_amdgcn_mov_dpp(__builtin_bit_cast(int, v), 0x4E, 0xF, 0xF, true));
  else return __builtin_bit_cast(float, __builtin_amdgcn_ds_swizzle(__builtin_bit_cast(int, v), 0x1f | (M << 10)));
}
namespace pg8 {
#define PG8_LAS __attribute__((address_space(3)))
typedef unsigned short bf16_t;
typedef short bf16x8 __attribute__((ext_vector_type(8)));
typedef float f32x4 __attribute__((ext_vector_type(4)));
typedef unsigned u32x4 __attribute__((ext_vector_type(4)));
typedef int v4i_t __attribute__((ext_vector_type(4)));
typedef int v8i_t __attribute__((ext_vector_type(8)));
constexpr int BM = 256, BK = 64, HALF = 128, HTB = HALF * BK * 2  , STAGE_BYTES = 8 * HTB, NXCD = 8, WGM = 8;

__host__ __device__ __forceinline__ int lds_byte(int r, int c) { const int st = (r >> 4) * 2 + (c >> 5), rr = r & 15, cc = c & 31, ob = rr * 64 + cc * 2; return st * 1024 + (ob ^ (((ob >> 9) & 1) << 5)); }
__host__ __device__ __forceinline__ void stage_rc(int b, int& R, int& C) { const int st = b / 1024, sb = b % 1024, swz = sb ^ (((sb >> 9) & 1) << 5); R = (st >> 1) * 16 + swz / 64; C = (st & 1) * 32 + (swz % 64) / 2; }
__host__ __device__ __forceinline__ int perm32(int rho) { const int n = rho >> 4, i = rho & 15; return 8 * (i >> 2) + 4 * n + (i & 3); }

struct Unit { int pm, pn; };
struct Gemm { const bf16_t* A; const bf16_t* Bt; int M, N, K; };

struct StaticOrder {
    int nM, nN, nwg, G, c;
    __host__ __device__ void init(int M, int N, int G_, int c_) { nM = M / BM; nN = N / BM; nwg = nM * nN; G = G_; c = c_; }
    __host__ __device__ bool next(int i, Unit& u) const {
        const long L = (long)i * G + c; if (L >= nwg) return false;
        int wgid = (int)L; { const int q = nwg / NXCD, r = nwg % NXCD, xcd = wgid % NXCD, off = wgid / NXCD; wgid = (xcd < r ? xcd * (q + 1) : r * (q + 1) + (xcd - r) * q) + off; }
        const int nig = WGM * nN, gid = wgid / nig, fm = gid * WGM, gsz = (nM - fm) < WGM ? (nM - fm) : WGM;
        u.pm = fm + ((wgid % nig) % gsz); u.pn = (wgid % nig) / gsz; return true;
    }
    __device__ __forceinline__ void a_ready(const Unit&) const {}
    __device__ __forceinline__ void done(const Unit&) const {}
};

struct PanelOrder { int lo, hi, nN, G, c;
    __device__ bool next(int i, Unit& u) const { const int L = lo + i * G + c; if (L >= hi) return false; u.pm = L / nN; u.pn = L - u.pm * nN; return true; }
    __device__ __forceinline__ void a_ready(const Unit&) const {}
    __device__ __forceinline__ void done(const Unit&) const {} };

struct DownOrder { int G, c;
    __device__ bool next(int i, Unit& u) const {
        int L;
        if (G == 256) { if (c < 48) { if (i > 0) return false; L = 624 + c; } else { if (i > 2) return false; L = i * 208 + (c - 48); } }
        else { L = i * G + c; if (L >= 672) return false; }
        if (L < 32) { u.pm = L >> 1; u.pn = L & 1; } else { const int l2 = L - 32; u.pm = 16 + l2 / 5; u.pn = l2 - (l2 / 5) * 5; }
        return true; }
    __device__ __forceinline__ void a_ready(const Unit&) const {}
    __device__ __forceinline__ void done(const Unit&) const {} };

__device__ __forceinline__ unsigned cvt_pk_bf16(float lo, float hi) { unsigned r; asm volatile("v_cvt_pk_bf16_f32 %0, %1, %2" : "=v"(r) : "v"(lo), "v"(hi)); return r; }
typedef float f32x2 __attribute__((ext_vector_type(2)));
__device__ __forceinline__ float silu_f(float a) { return a * __builtin_amdgcn_rcpf(1.0f + __builtin_amdgcn_exp2f(a * -1.4426950408889634f)); }
__device__ __forceinline__ int cond_of_panel(int pm) { return pm < 16 ? 0 : 1 + ((pm - 16) >> 4); }
constexpr int MODROW = 2 * 9 * 2048;

__device__ __forceinline__ float clamp448(float x) { return __builtin_fminf(__builtin_fmaxf(x, -448.0f), 448.0f); }
__device__ __forceinline__ unsigned pk4_fp8(float a, float b, float c, float d) { int p = __builtin_amdgcn_cvt_pk_fp8_f32(clamp448(a), clamp448(b), 0, false); p = __builtin_amdgcn_cvt_pk_fp8_f32(clamp448(c), clamp448(d), p, true); return (unsigned)p; }
constexpr float W13_SCALE = 64.0f, W2_SCALE = 128.0f;
struct EpiSwiGLU {
    static constexpr bool PERM = true, AFTER_DRAIN = false;
    unsigned char* O; int ldc;
    static __device__ __forceinline__ f32x2 g2(f32x2 a, f32x2 b) {
        constexpr float S = 1.0f / W13_SCALE;
        const f32x2 t = a * (-1.4426950408889634f * S); f32x2 e; e.x = __builtin_amdgcn_exp2f(t.x); e.y = __builtin_amdgcn_exp2f(t.y);
        const f32x2 d = e + 1.0f; f32x2 r; r.x = __builtin_amdgcn_rcpf(d.x); r.y = __builtin_amdgcn_rcpf(d.y);
        return (a * b) * (r * (S * S));
    }
    static __device__ __forceinline__ unsigned pk4(f32x2 lo, f32x2 hi) { int p = __builtin_amdgcn_cvt_pk_fp8_f32(lo.x, lo.y, 0, false); p = __builtin_amdgcn_cvt_pk_fp8_f32(hi.x, hi.y, p, true); return (unsigned)p; }
    __device__ __forceinline__ void operator()(const f32x4 (&acc)[2][2][4][2], const Unit& u, int wr, int wc, int fr, int fq) const {
        const int row0 = u.pm * BM + wr * 64 + fr, col0 = u.pn * HALF + wc * 32 + 8 * fq;
#pragma unroll
        for (int ai = 0; ai < 2; ++ai)
#pragma unroll
            for (int m = 0; m < 4; ++m) { unsigned char* rowp = O + (size_t)(row0 + ai * HALF + m * 16) * ldc + col0;
                const f32x4 a0 = acc[ai][0][m][0], a1 = acc[ai][0][m][1], b0 = acc[ai][1][m][0], b1 = acc[ai][1][m][1];
                typedef unsigned u32x2_t __attribute__((ext_vector_type(2)));
                u32x2_t w; w.x = pk4(g2((f32x2){a0[0], a0[1]}, (f32x2){b0[0], b0[1]}), g2((f32x2){a0[2], a0[3]}, (f32x2){b0[2], b0[3]}));
                w.y = pk4(g2((f32x2){a1[0], a1[1]}, (f32x2){b1[0], b1[1]}), g2((f32x2){a1[2], a1[3]}, (f32x2){b1[2], b1[3]}));
                *(u32x2_t*)rowp = w; }
    }
};
typedef _Float16 h16x8 __attribute__((ext_vector_type(8)));
typedef float f32x8_t __attribute__((ext_vector_type(8)));
struct EpiResid {
    static constexpr bool PERM = true, AFTER_DRAIN = false;
    bf16_t* T; const float* gate0;
    const float* stats; const float* lng; const float* lnb; double coef_d;
    static constexpr float alpha = 1.4142135623730951f;
    __device__ __forceinline__ void operator()(const f32x4 (&acc)[2][2][4][2], const Unit& u, int wr, int wc, int fr, int fq) const {
        typedef float f32x2_t __attribute__((ext_vector_type(2)));
        const int row0 = u.pm * BM + wr * 64 + fr, col0 = u.pn * BM + wc * 32 + 8 * fq;
        const float* gp = gate0 + (size_t)cond_of_panel(u.pm) * MODROW + col0; const float coef = (float)coef_d;
        const unsigned o0 = ((unsigned)row0 * 2048u + (unsigned)col0) * 2u, os0 = (unsigned)row0 * 8u;
        h16x8 hA[4], hB[4]; f32x2_t sA[4], sB[4];
#define RES_LOAD(H, S, bj, ai) do { _Pragma("unroll") for (int m = 0; m < 4; ++m) { const size_t ro = (size_t)((ai) * HALF + m * 16) * 2048 + (bj) * HALF; \
            S[m] = *(const f32x2_t*)((const char*)stats + (size_t)((ai) * HALF + m * 16) * 8 + os0); H[m] = *(const h16x8*)((const char*)(T + ro) + o0); } } while (0)
#define RES_STORE(H, S, bj, ai) do { f32x4 gv[2], G[2], B[2]; \
            _Pragma("unroll") for (int n = 0; n < 2; ++n) { const int c = col0 + (bj) * HALF + 4 * n; gv[n] = *(const f32x4*)(gp + (bj) * HALF + 4 * n) * coef; G[n] = *(const f32x4*)(lng + c) * alpha; B[n] = *(const f32x4*)(lnb + c) * alpha; } \
            _Pragma("unroll") for (int m = 0; m < 4; ++m) { const size_t ro = (size_t)((ai) * HALF + m * 16) * 2048 + (bj) * HALF; \
                const f32x8_t wf = __builtin_convertvector(H[m], f32x8_t); const f32x4 t0 = (f32x4){wf[0], wf[1], wf[2], wf[3]}, t1 = (f32x4){wf[4], wf[5], wf[6], wf[7]}; \
                const f32x4 v0 = G[0] * (t0 * S[m].x + S[m].y) + (gv[0] * acc[ai][bj][m][0] + B[0]), v1 = G[1] * (t1 * S[m].x + S[m].y) + (gv[1] * acc[ai][bj][m][1] + B[1]); \
                const f32x8_t vf = (f32x8_t){v0[0], v0[1], v0[2], v0[3], v1[0], v1[1], v1[2], v1[3]}; \
                *(h16x8*)((char*)(T + ro) + o0) = __builtin_convertvector(vf, h16x8); } } while (0)
        RES_LOAD(hA, sA, 0, 0); RES_LOAD(hB, sB, 0, 1);
        RES_STORE(hA, sA, 0, 0); RES_LOAD(hA, sA, 1, 0);
        RES_STORE(hB, sB, 0, 1); RES_LOAD(hB, sB, 1, 1);
        RES_STORE(hA, sA, 1, 0);
        RES_STORE(hB, sB, 1, 1);
#undef RES_LOAD
#undef RES_STORE
    }
};
struct EpiF32 {
    static constexpr bool PERM = false, AFTER_DRAIN = false;
    float* C; int ldc;
    __device__ __forceinline__ void operator()(const f32x4 (&acc)[2][2][4][2], const Unit& u, int wr, int wc, int fr, int fq) const {
        const int row0 = u.pm * BM + wr * 64 + fr, col0 = u.pn * BM + wc * 32 + 4 * fq;
#pragma unroll
        for (int ai = 0; ai < 2; ++ai)
#pragma unroll
            for (int m = 0; m < 4; ++m) { float* rowp = C + (size_t)(row0 + ai * HALF + m * 16) * ldc + col0;
#pragma unroll
                for (int bj = 0; bj < 2; ++bj)
#pragma unroll
                    for (int n = 0; n < 2; ++n) *(f32x4*)(rowp + bj * HALF + n * 16) = acc[ai][bj][m][n]; }
    }
};
struct EpiF16 {
    static constexpr bool PERM = true, AFTER_DRAIN = false;
    bf16_t* O; long ldc; double scale_d;
    __device__ __forceinline__ void operator()(const f32x4 (&acc)[2][2][4][2], const Unit& u, int wr, int wc, int fr, int fq) const {
        const int row0 = u.pm * BM + wr * 64 + fr, col0 = u.pn * BM + wc * 32 + 8 * fq; const float sc = (float)scale_d;
#pragma unroll
        for (int ai = 0; ai < 2; ++ai)
#pragma unroll
            for (int m = 0; m < 4; ++m) { bf16_t* rowp = O + (size_t)(row0 + ai * HALF + m * 16) * ldc + col0;
#pragma unroll
                for (int bj = 0; bj < 2; ++bj) { const f32x4 v0 = acc[ai][bj][m][0] * sc, v1 = acc[ai][bj][m][1] * sc;
                    h16x8 w = {(_Float16)v0[0], (_Float16)v0[1], (_Float16)v0[2], (_Float16)v0[3], (_Float16)v1[0], (_Float16)v1[1], (_Float16)v1[2], (_Float16)v1[3]};
                    *(h16x8*)(rowp + bj * HALF) = w; } }
    }
};
struct EpiBf16 {
    static constexpr bool PERM = true, AFTER_DRAIN = false;
    bf16_t* O; long ldc; long split_cols; size_t split_stride; double scale_d; long skip_panels;
    __device__ __forceinline__ void operator()(const f32x4 (&acc)[2][2][4][2], const Unit& u, int wr, int wc, int fr, int fq) const {
        const int row0 = u.pm * BM + wr * 64 + fr; int colt = u.pn * BM; bf16_t* base = O; int t = 0; const float sc = (float)scale_d;
        if (split_cols) { t = colt / (int)split_cols; base += (size_t)t * split_stride; colt -= t * (int)split_cols; }
        if (u.pm < (int)skip_panels && (t == 1 || t == 2)) return;
        const int col0 = colt + wc * 32 + 8 * fq;
#pragma unroll
        for (int ai = 0; ai < 2; ++ai)
#pragma unroll
            for (int m = 0; m < 4; ++m) { bf16_t* rowp = base + (size_t)(row0 + ai * HALF + m * 16) * ldc + col0;
#pragma unroll
                for (int bj = 0; bj < 2; ++bj) { const f32x4 v0 = acc[ai][bj][m][0] * sc, v1 = acc[ai][bj][m][1] * sc;
                    u32x4 w; w.x = cvt_pk_bf16(v0[0], v0[1]); w.y = cvt_pk_bf16(v0[2], v0[3]); w.z = cvt_pk_bf16(v1[0], v1[1]); w.w = cvt_pk_bf16(v1[2], v1[3]);
                    *(u32x4*)(rowp + bj * HALF) = w; } }
    }
};
struct EpiQRope {
    static constexpr bool PERM = true, AFTER_DRAIN = false;
    unsigned char* O; long tab_lds;
    __device__ __forceinline__ void operator()(const f32x4 (&acc)[2][2][4][2], const Unit& u, int wr, int wc, int fr, int fq) const {
        const int row0 = u.pm * BM + wr * 64 + fr, col0 = u.pn * BM + wc * 32 + 8 * fq;
        const bool lat = u.pm >= 16; const int prow_base = ((u.pm - 16) & 15) * 4 + wr;
#pragma unroll
        for (int bj = 0; bj < 2; ++bj) { const int grp = u.pn * 8 + bj * 4 + wc, gi = grp % 6;
            const bool rot = lat && gi >= 4;
            f32x4 tc[4], ts[4];
            if (rot) {
#pragma unroll
                for (int k = 0; k < 4; ++k) { const int pos = (gi == 4) ? (prow_base + 2 * (k & 1)) : (16 * k + fr);
                    typedef __attribute__((address_space(3))) const f32x4 LF4; LF4* tp = (LF4*)(unsigned)((unsigned)tab_lds + (unsigned)((pos * 16 + 4 * fq) * 8)); const f32x4 t0 = tp[0], t1 = tp[1];
                    tc[k] = (f32x4){t0[0], t0[2], t1[0], t1[2]}; ts[k] = (f32x4){t0[1], t0[3], t1[1], t1[3]}; }
            }
#pragma unroll
            for (int ai = 0; ai < 2; ++ai)
#pragma unroll
                for (int m = 0; m < 4; ++m) { f32x4 v0 = acc[ai][bj][m][0] * (1.0f / 32.0f), v1 = acc[ai][bj][m][1] * (1.0f / 32.0f);
                    if (rot) { const int k = (gi == 4) ? ai : m; const f32x4 cs = tc[k], sn = ts[k], x1 = v0, x2 = v1; v0 = x1 * cs - x2 * sn; v1 = x2 * cs + x1 * sn; }
                    typedef unsigned u32x2_t __attribute__((ext_vector_type(2)));
                    u32x2_t w; w.x = pk4_fp8(v0[0], v0[1], v0[2], v0[3]); w.y = pk4_fp8(v1[0], v1[1], v1[2], v1[3]);
                    *(u32x2_t*)(O + (size_t)(row0 + ai * HALF + m * 16) * 3072 + col0 + bj * HALF) = w; } }
    }
};
struct EpiKV8 {
    static constexpr bool PERM = true, AFTER_DRAIN = false;
    unsigned char* K8; unsigned char* VT; double scale_d;
    __device__ __forceinline__ void operator()(const f32x4 (&acc)[2][2][4][2], const Unit& u, int wr, int wc, int fr, int fq) const {
        typedef unsigned u32x2_t __attribute__((ext_vector_type(2)));
        const float sc = (float)scale_d;
        const int row0 = u.pm * BM + wr * 64 + fr, col0 = u.pn * HALF + wc * 32 + 8 * fq;
        unsigned char* kp = K8 + (size_t)row0 * 2048 + col0;
        const int q = fr & 3; unsigned char* vp = VT + (size_t)(col0 + q) * 38912 + (row0 - q);
        const unsigned sel1 = (q & 1) ? 0x03070105u : 0x06020400u, sel2 = (q & 2) ? 0x03020706u : 0x05040100u;
#pragma unroll
        for (int ai = 0; ai < 2; ++ai)
#pragma unroll
            for (int m = 0; m < 4; ++m) { const int rs = ai * HALF + m * 16;
                const f32x4 k0 = acc[ai][0][m][0] * sc, k1 = acc[ai][0][m][1] * sc, v0 = acc[ai][1][m][0] * sc, v1 = acc[ai][1][m][1] * sc;
                u32x2_t wk; wk.x = pk4_fp8(k0[0], k0[1], k0[2], k0[3]); wk.y = pk4_fp8(k1[0], k1[1], k1[2], k1[3]); *(u32x2_t*)(kp + (size_t)rs * 2048) = wk;
                const unsigned w0 = pk4_fp8(v0[0], v0[1], v0[2], v0[3]), w1 = pk4_fp8(v1[0], v1[1], v1[2], v1[3]);
#pragma unroll
                for (int hf = 0; hf < 2; ++hf) { const unsigned w = hf ? w1 : w0;
                    const unsigned x = __builtin_amdgcn_perm((unsigned)__builtin_amdgcn_mov_dpp((int)w, 0xB1, 0xF, 0xF, true), w, sel1);
                    const unsigned y = __builtin_amdgcn_perm((unsigned)__builtin_amdgcn_mov_dpp((int)x, 0x4E, 0xF, 0xF, true), x, sel2);
                    *(unsigned*)(vp + (size_t)(4 * hf) * 38912 + rs) = y; } }
    }
};


template <class Epi, class Sched, bool ALIGN_EPI = false, bool SP2 = false, bool F8 = false>
__device__ __forceinline__ void gemm_phase(PG8_LAS unsigned char* lds, const Gemm g, const Sched& S, const Epi& E, const int wid0) {
    int wid_ = wid0; asm volatile("" : "+s"(wid_));
    const int wid = wid_, lane = hw_lane(), tid = wid * 64 + lane, wr = wid >> 2, wc = wid & 3, fr = lane & 15, fq = lane >> 4;
    const int K = g.K, nt = K / BK;
    unsigned voffA[1], voffB[1];
    { int R, C; stage_rc(tid * 16, R, C); const int Rb = Epi::PERM ? ((R & ~31) + perm32(R & 31)) : R;
        voffA[0] = (unsigned)(R * K + C) * 2u; voffB[0] = (unsigned)(Rb * K + C) * 2u; }
    const size_t piece2 = (size_t)64 * K * 2;
    const size_t kstep = (size_t)(BK * 2);
    const size_t hstep = (size_t)HALF * K * 2;
    const size_t tstep = 2 * hstep;
    const unsigned ldsbase_u = __builtin_amdgcn_readfirstlane((unsigned)(unsigned long long)lds);
    const unsigned ldsw = (unsigned)wid * 1024u;
    const int aoff = lds_byte(wr * 64 + fr, fq * 8), boff = lds_byte(wc * 32 + fr, fq * 8);
    PG8_LAS unsigned char* abase = lds + aoff; PG8_LAS unsigned char* bbase = lds + 4 * HTB + boff; asm volatile("" : "+v"(abase), "+v"(bbase));
#define PG8_SA(b, h) (((b) * 2 + (h)) * HTB)
#define PG8_SB(b, h) ((4 + (b) * 2 + (h)) * HTB)
#define PG8_STAGE(bufoff, gbase, voff) do { _Pragma("unroll") for (int _i = 0; _i < 2; ++_i) { const unsigned long long gb_ = (unsigned long long)(gbase) + (unsigned long long)_i * piece2; \
        const unsigned glo_ = __builtin_amdgcn_readfirstlane((unsigned)gb_), ghi_ = __builtin_amdgcn_readfirstlane((unsigned)(gb_ >> 32)); const unsigned long long gs_ = ((unsigned long long)ghi_ << 32) | glo_; unsigned keep_; \
        asm volatile("s_mov_b32 %0, m0\n\ts_mov_b32 m0, %3\n\ts_nop 0\n\tglobal_load_lds_dwordx4 %1, %2\n\ts_mov_b32 m0, %0" : "=&s"(keep_) : "v"((voff)[0]), "s"(gs_), "s"(ldsbase_u + (unsigned)(bufoff) + ldsw + _i * 8192u) : "memory"); } } while (0)
#define PG8_LD16A(off) (*(const PG8_LAS bf16x8*)(abase + (off)))
#define PG8_LD16B(off) (*(const PG8_LAS bf16x8*)(bbase + (off)))
#define PG8_CAT8(x, y) __builtin_shufflevector(__builtin_bit_cast(v4i_t, x), __builtin_bit_cast(v4i_t, y), 0, 1, 2, 3, 4, 5, 6, 7)
#define PG8_LDA(dst, b, h) do { if constexpr (F8) { _Pragma("unroll") for (int m = 0; m < 4; ++m) dst##8[m] = PG8_CAT8(PG8_LD16A(PG8_SA(b, h) + m * 2048), PG8_LD16A(PG8_SA(b, h) + m * 2048 + 1024)); } \
    else { _Pragma("unroll") for (int m = 0; m < 4; ++m) _Pragma("unroll") for (int k = 0; k < 2; ++k) dst[m][k] = PG8_LD16A(PG8_SA(b, h) + m * 2048 + k * 1024); } } while (0)
#define PG8_LDB(dst, b, h) do { if constexpr (F8) { _Pragma("unroll") for (int n = 0; n < 2; ++n) dst##8[n] = PG8_CAT8(PG8_LD16B(PG8_SB(b, h) - 4 * HTB + n * 2048), PG8_LD16B(PG8_SB(b, h) - 4 * HTB + n * 2048 + 1024)); } \
    else { _Pragma("unroll") for (int n = 0; n < 2; ++n) _Pragma("unroll") for (int k = 0; k < 2; ++k) dst[n][k] = PG8_LD16B(PG8_SB(b, h) - 4 * HTB + n * 2048 + k * 1024); } } while (0)
#define PG8_MMA(ai, bj, At, Bt) do { __builtin_amdgcn_s_setprio(1); if constexpr (F8) { _Pragma("unroll") for (int m = 0; m < 4; ++m) _Pragma("unroll") for (int n = 0; n < 2; ++n) \
        acc[ai][bj][m][n] = __builtin_amdgcn_mfma_scale_f32_16x16x128_f8f6f4(Bt##8[n], At##8[m], acc[ai][bj][m][n], 0, 0, 0, 0, 0, 0); } \
    else { _Pragma("unroll") for (int m = 0; m < 4; ++m) _Pragma("unroll") for (int n = 0; n < 2; ++n) _Pragma("unroll") for (int k = 0; k < 2; ++k) \
        acc[ai][bj][m][n] = __builtin_amdgcn_mfma_f32_16x16x32_bf16(Bt[n][k], At[m][k], acc[ai][bj][m][n], 0, 0, 0); } __builtin_amdgcn_s_setprio(0); } while (0)
#define PG8_WAIT_V(n) asm volatile("s_waitcnt vmcnt(" #n ")" ::: "memory")
#define PG8_WAIT_L(n) asm volatile("s_waitcnt lgkmcnt(" #n ")" ::: "memory")
#define PG8_BAR __builtin_amdgcn_s_barrier()
#define PG8_SCHED __builtin_amdgcn_sched_barrier(0)
    Unit cur, nxt; int ui = 0;
    if (!S.next(0, cur)) return;
    f32x4 acc[2][2][4][2];
#pragma unroll
    for (int a = 0; a < 2; ++a)
#pragma unroll
        for (int b = 0; b < 2; ++b)
#pragma unroll
            for (int m = 0; m < 4; ++m)
#pragma unroll
                for (int n = 0; n < 2; ++n) acc[a][b][m][n] = (f32x4){0.f, 0.f, 0.f, 0.f};
    bf16x8 At[4][2], B0[2][2], B1[2][2]; v8i_t At8[4], B08[2], B18[2];
    const char* cA = (const char*)g.A + (size_t)cur.pm * tstep; const char* cB = (const char*)g.Bt + (size_t)cur.pn * tstep;
    S.a_ready(cur);
    if constexpr (SP2) {
        PG8_STAGE(PG8_SB(0, 0), cB, voffB); PG8_STAGE(PG8_SB(0, 1), cB + hstep, voffB); PG8_STAGE(PG8_SA(0, 0), cA, voffA); PG8_STAGE(PG8_SA(0, 1), cA + hstep, voffA);
        if (wr == 1) PG8_BAR;
        PG8_WAIT_V(2); PG8_BAR;
        PG8_STAGE(PG8_SB(1, 0), cB + kstep, voffB); PG8_STAGE(PG8_SA(1, 0), cA + kstep, voffA); PG8_STAGE(PG8_SB(1, 1), cB + hstep + kstep, voffB);
        PG8_WAIT_V(6); PG8_BAR;
    } else {
        PG8_STAGE(PG8_SB(0, 0), cB, voffB); PG8_STAGE(PG8_SA(0, 0), cA, voffA); PG8_STAGE(PG8_SB(0, 1), cB + hstep, voffB); PG8_STAGE(PG8_SA(0, 1), cA + hstep, voffA);
        if (wr == 1) PG8_BAR;
        PG8_WAIT_V(4); PG8_BAR;
        PG8_STAGE(PG8_SB(1, 0), cB + kstep, voffB); PG8_STAGE(PG8_SA(1, 0), cA + kstep, voffA); PG8_STAGE(PG8_SB(1, 1), cB + hstep + kstep, voffB);
        PG8_WAIT_V(6); PG8_BAR;
    }
    for (;;) {
        const bool has_next = S.next(ui + 1, nxt);
        const char* nA = has_next ? (const char*)g.A + (size_t)nxt.pm * tstep : cA; const char* nB = has_next ? (const char*)g.Bt + (size_t)nxt.pn * tstep : cB;
#pragma unroll 1
        for (int t = 0; t < nt; t += 2) {
            const bool last = (t == nt - 2);
            const char* a1 = cA + (size_t)(t + 1) * kstep;
            const char* a2 = last ? nA : cA + (size_t)(t + 2) * kstep; const char* b2 = last ? nB : cB + (size_t)(t + 2) * kstep;
            const char* a3 = a2 + kstep; const char* b3 = b2 + kstep;
            if (last && has_next) S.a_ready(nxt);
            if constexpr (SP2) {
            PG8_LDB(B0, 0, 0); PG8_LDB(B1, 0, 1); PG8_SCHED; PG8_LDA(At, 0, 0); PG8_STAGE(PG8_SA(1, 1), a1 + hstep, voffA);
            PG8_WAIT_V(8); PG8_WAIT_L(0); PG8_BAR; PG8_MMA(0, 0, At, B0); PG8_MMA(0, 1, At, B1); PG8_BAR; PG8_SCHED;
            PG8_LDA(At, 0, 1); PG8_STAGE(PG8_SB(0, 0), b2, voffB); PG8_STAGE(PG8_SB(0, 1), b2 + hstep, voffB); PG8_STAGE(PG8_SA(0, 0), a2, voffA);
            PG8_WAIT_V(8); PG8_WAIT_L(0); PG8_BAR; PG8_MMA(1, 0, At, B0); PG8_MMA(1, 1, At, B1); PG8_BAR; PG8_SCHED;
            PG8_LDB(B0, 1, 0); PG8_LDB(B1, 1, 1); PG8_SCHED; PG8_LDA(At, 1, 0); PG8_STAGE(PG8_SA(0, 1), a2 + hstep, voffA);
            PG8_WAIT_V(8); PG8_WAIT_L(0); PG8_BAR; PG8_MMA(0, 0, At, B0); PG8_MMA(0, 1, At, B1); PG8_BAR; PG8_SCHED;
            PG8_LDA(At, 1, 1); PG8_STAGE(PG8_SB(1, 0), b3, voffB); PG8_STAGE(PG8_SB(1, 1), b3 + hstep, voffB); PG8_STAGE(PG8_SA(1, 0), a3, voffA);
            PG8_WAIT_V(8); PG8_WAIT_L(0); PG8_BAR; PG8_MMA(1, 0, At, B0); PG8_MMA(1, 1, At, B1); PG8_BAR; PG8_SCHED;
            } else {
            PG8_LDB(B0, 0, 0); PG8_SCHED; PG8_LDA(At, 0, 0); PG8_STAGE(PG8_SA(1, 1), a1 + hstep, voffA);
            PG8_WAIT_L(8); PG8_BAR; PG8_WAIT_L(0); PG8_MMA(0, 0, At, B0); PG8_BAR; PG8_SCHED;
            PG8_LDB(B1, 0, 1); PG8_STAGE(PG8_SB(0, 0), b2, voffB);
            PG8_BAR; PG8_WAIT_L(0); PG8_MMA(0, 1, At, B1); PG8_BAR;
            PG8_LDA(At, 0, 1); PG8_STAGE(PG8_SA(0, 0), a2, voffA);
            PG8_BAR; PG8_WAIT_L(0); PG8_MMA(1, 0, At, B0); PG8_BAR; PG8_SCHED;
            PG8_STAGE(PG8_SB(0, 1), b2 + hstep, voffB);
            PG8_WAIT_V(6); PG8_BAR; PG8_MMA(1, 1, At, B1); PG8_BAR;
            PG8_LDB(B0, 1, 0); PG8_SCHED; PG8_LDA(At, 1, 0); PG8_STAGE(PG8_SA(0, 1), a2 + hstep, voffA);
            PG8_WAIT_L(8); PG8_BAR; PG8_WAIT_L(0); PG8_MMA(0, 0, At, B0); PG8_BAR; PG8_SCHED;
            PG8_LDB(B1, 1, 1); PG8_STAGE(PG8_SB(1, 0), b3, voffB);
            PG8_BAR; PG8_WAIT_L(0); PG8_MMA(0, 1, At, B1); PG8_BAR;
            PG8_LDA(At, 1, 1); PG8_STAGE(PG8_SA(1, 0), a3, voffA);
            PG8_BAR; PG8_WAIT_L(0); PG8_MMA(1, 0, At, B0); PG8_BAR; PG8_SCHED;
            PG8_STAGE(PG8_SB(1, 1), b3 + hstep, voffB);
            PG8_WAIT_V(6); PG8_BAR; PG8_MMA(1, 1, At, B1); PG8_BAR;
            }
        }
        if constexpr (ALIGN_EPI) { if (wr == 0) PG8_BAR; }
        if constexpr (!Epi::AFTER_DRAIN) { const int l2_ = hw_lane();
            E(acc, cur, wr, wc, l2_ & 15, l2_ >> 4); S.done(cur); }
        if (!has_next) break;
#pragma unroll
        for (int a = 0; a < 2; ++a)
#pragma unroll
            for (int b = 0; b < 2; ++b)
#pragma unroll
                for (int m = 0; m < 4; ++m)
#pragma unroll
                    for (int n = 0; n < 2; ++n) acc[a][b][m][n] = (f32x4){0.f, 0.f, 0.f, 0.f};
        cur = nxt; cA = nA; cB = nB; ++ui;
        if constexpr (ALIGN_EPI) { if (wr == 1) PG8_BAR; }
    }
    PG8_WAIT_V(0);
    if constexpr (!ALIGN_EPI) { if (wr == 0) PG8_BAR; }
    PG8_BAR;
    if constexpr (Epi::AFTER_DRAIN) { E.fused(acc, cur, wr, wc, fr, fq, lds, wid, lane); S.done(cur); }
#undef PG8_SA
#undef PG8_SB
#undef PG8_STAGE
#undef PG8_LDA
#undef PG8_LDB
#undef PG8_MMA
#undef PG8_CAT8
#undef PG8_LD16A
#undef PG8_LD16B
#undef PG8_WAIT_V
#undef PG8_WAIT_L
#undef PG8_BAR
#undef PG8_SCHED
}
}
namespace att {
using bf16x8 = __attribute__((ext_vector_type(8))) short;
using s16x4  = __attribute__((ext_vector_type(4))) short;
using f32x16 = __attribute__((ext_vector_type(16))) float;
using u32x4  = __attribute__((ext_vector_type(4))) unsigned;
typedef unsigned short bf16;
constexpr int NW = 8, QBLK = 32, KVBLK = 64;
constexpr int VT_PITCH = 38912;
constexpr float O_SCALE = 16.0f;
constexpr float THR_L2 = 11.5f;
constexpr int SHM_V = KVBLK * 128 * 2, SHM_K = KVBLK * 128 * 2, SHM_KR = KVBLK * 64 * 2;
constexpr int OFF_V = 0, OFF_K = 3 * SHM_V, OFF_KR = OFF_K + 3 * SHM_K, OFF_WS = OFF_KR + 3 * SHM_KR, OFF_RPB = OFF_WS + NW * 64 * 4 + 1024, ATT_LDS = OFF_RPB + 512 * 4 + 1024;
#define KSWZ(row, colB) ((row) * 256 + ((colB) ^ (((row) & 15) << 4)))
#define KRSWZ(row, c16) ((row) * 128 + ((((c16) ^ (((row) >> 1) & 7))) << 4))
#define SBAR() __builtin_amdgcn_sched_barrier(0)
__device__ __forceinline__ int crow(int r, int hi) { return (r & 3) + 8 * (r >> 2) + 4 * hi; }
__device__ __forceinline__ unsigned cvtpk(float lo, float hi) { unsigned r; asm volatile("v_cvt_pk_bf16_f32 %0, %1, %2" : "=v"(r) : "v"(lo), "v"(hi)); return r; }

template <bool PRE, bool LOWTHR = false, bool NOEXP = false> __device__ __forceinline__ void partialSM(f32x16& p0, f32x16& p1, float& m_reg, float& mn, float& alpha, const float C) {
  constexpr float THR = LOWTHR ? 8.0f : THR_L2;
  float pmax = p0[0];
#pragma unroll
  for (int r = 1; r < 16; ++r) pmax = fmaxf(pmax, p0[r]);
#pragma unroll
  for (int r = 0; r < 16; ++r) pmax = fmaxf(pmax, p1[r]);
  { auto rr = __builtin_amdgcn_permlane32_swap(__float_as_uint(pmax), __float_as_uint(pmax), false, false);
    pmax = fmaxf(__uint_as_float(rr[0]), __uint_as_float(rr[1])); }
  const float CC = PRE ? 1.0f : C;
  if (__builtin_expect(__all((pmax - m_reg) * CC <= THR), 1)) { mn = m_reg; alpha = 1.f; }
  else { mn = fmaxf(m_reg, pmax); alpha = __builtin_amdgcn_exp2f((m_reg - mn) * CC); m_reg = mn; }
  const float mnC = -mn * CC;
#pragma unroll
  for (int r = 0; r < 16; ++r) p0[r] = PRE ? (p0[r] + mnC) : fmaf(p0[r], CC, mnC);
#pragma unroll
  for (int r = 0; r < 16; ++r) p1[r] = PRE ? (p1[r] + mnC) : fmaf(p1[r], CC, mnC);
#pragma unroll
  for (int r = 0; r < 16; ++r) p0[r] = NOEXP ? p0[r] : __builtin_amdgcn_exp2f(p0[r]);
}
__device__ __forceinline__ void finishSM(f32x16& p0, f32x16& p1, float alpha, float& l_reg, bf16x8& pa0, bf16x8& pa1, bf16x8& pa2, bf16x8& pa3) {
#pragma unroll
  for (int r = 0; r < 16; ++r) p1[r] = __builtin_amdgcn_exp2f(p1[r]);
  float ps = 0;
#pragma unroll
  for (int r = 0; r < 16; ++r) ps += p0[r];
#pragma unroll
  for (int r = 0; r < 16; ++r) ps += p1[r];
  { auto rr = __builtin_amdgcn_permlane32_swap(__float_as_uint(ps), __float_as_uint(ps), false, false);
    ps = __uint_as_float(rr[0]) + __uint_as_float(rr[1]); }
  l_reg = l_reg * alpha + ps;
#define PK4(P, BASE, OUT) do { unsigned a0 = cvtpk(P[BASE + 0], P[BASE + 1]), a1 = cvtpk(P[BASE + 2], P[BASE + 3]);   \
    unsigned b0 = cvtpk(P[BASE + 4], P[BASE + 5]), b1 = cvtpk(P[BASE + 6], P[BASE + 7]);                              \
    auto r0 = __builtin_amdgcn_permlane32_swap(a0, b0, false, false); auto r1 = __builtin_amdgcn_permlane32_swap(a1, b1, false, false); \
    u32x4 w = {r0[0], r1[0], r0[1], r1[1]}; OUT = *reinterpret_cast<bf16x8*>(&w); } while (0)
  PK4(p0, 0, pa0); PK4(p0, 8, pa1); PK4(p1, 0, pa2); PK4(p1, 8, pa3);
#undef PK4
}
template <int ND0> __device__ __forceinline__ void qkt(f32x16& p0, f32x16& p1, const char* Ks, const char* KRs, const bf16x8* qr, int r32, int hi) {
  p0 = f32x16{}; p1 = f32x16{};
#pragma unroll
  for (int d0 = 0; d0 < 8; ++d0) { const int cb = (d0 * 16 + hi * 8) * 2;
    const bf16x8 b0 = *reinterpret_cast<const bf16x8*>(Ks + KSWZ(r32, cb));
    const bf16x8 b1 = *reinterpret_cast<const bf16x8*>(Ks + KSWZ(32 + r32, cb));
    p0 = __builtin_amdgcn_mfma_f32_32x32x16_bf16(b0, qr[d0], p0, 0, 0, 0);
    p1 = __builtin_amdgcn_mfma_f32_32x32x16_bf16(b1, qr[d0], p1, 0, 0, 0); }
  if constexpr (ND0 > 8) {
#pragma unroll
    for (int d0 = 8; d0 < ND0; ++d0) { const int c16 = (d0 - 8) * 2 + hi;
      const bf16x8 b0 = *reinterpret_cast<const bf16x8*>(KRs + KRSWZ(r32, c16));
      const bf16x8 b1 = *reinterpret_cast<const bf16x8*>(KRs + KRSWZ(32 + r32, c16));
      p0 = __builtin_amdgcn_mfma_f32_32x32x16_bf16(b0, qr[d0], p0, 0, 0, 0);
      p1 = __builtin_amdgcn_mfma_f32_32x32x16_bf16(b1, qr[d0], p1, 0, 0, 0); }
  }
}
__device__ __forceinline__ int v_st(int k, int c) { const int kk = (k & ~0xC) | ((k & 4) << 1) | ((k & 8) >> 1); return ((kk >> 3) * 4 + (c >> 5)) * 512 + ((kk & 7) * 32 + (c & 31)) * 2; }
__device__ __forceinline__ int v_rd_base(int lane) { return ((lane & 3) << 3) | (((lane >> 2) & 3) << 6) | (((lane >> 4) & 1) << 5) | (((lane >> 5) & 1) << 8); }
constexpr int v_rd_off(int d0, int ks, int half) { return d0 * 512 + ks * 4096 + half * 2048; }
template <int OFF> __device__ __forceinline__ s16x4 tr_read(int vb) {
  s16x4 r; asm volatile("ds_read_b64_tr_b16 %0, %1 offset:%2" : "=&v"(r) : "v"(vb), "i"(OFF) : "memory"); return r;
}
struct VFrag { s16x4 l0, h0, l1, h1, l2, h2, l3, h3; };
template <int D0> __device__ __forceinline__ void v_reads(VFrag& f, int vb) {
  f.l0 = tr_read<v_rd_off(D0, 0, 0)>(vb); f.h0 = tr_read<v_rd_off(D0, 0, 1)>(vb); f.l1 = tr_read<v_rd_off(D0, 1, 0)>(vb); f.h1 = tr_read<v_rd_off(D0, 1, 1)>(vb);
  f.l2 = tr_read<v_rd_off(D0, 2, 0)>(vb); f.h2 = tr_read<v_rd_off(D0, 2, 1)>(vb); f.l3 = tr_read<v_rd_off(D0, 3, 0)>(vb); f.h3 = tr_read<v_rd_off(D0, 3, 1)>(vb);
}
__device__ __forceinline__ void pv_mma(f32x16& od, const VFrag& f, bf16x8 pa0, bf16x8 pa1, bf16x8 pa2, bf16x8 pa3) {
#define PK(L, H) (bf16x8){L[0], L[1], L[2], L[3], H[0], H[1], H[2], H[3]}
  od = __builtin_amdgcn_mfma_f32_32x32x16_bf16(pa0, PK(f.l0, f.h0), od, 0, 0, 0);
  od = __builtin_amdgcn_mfma_f32_32x32x16_bf16(pa1, PK(f.l1, f.h1), od, 0, 0, 0);
  od = __builtin_amdgcn_mfma_f32_32x32x16_bf16(pa2, PK(f.l2, f.h2), od, 0, 0, 0);
  od = __builtin_amdgcn_mfma_f32_32x32x16_bf16(pa3, PK(f.l3, f.h3), od, 0, 0, 0);
#undef PK
}
__device__ __forceinline__ void pv_d0(f32x16* o, int vb, bf16x8 pa0, bf16x8 pa1, bf16x8 pa2, bf16x8 pa3) {
  VFrag fa, fb;
  v_reads<0>(fa, vb); v_reads<1>(fb, vb);
  asm volatile("s_waitcnt lgkmcnt(8)" ::: "memory"); SBAR(); pv_mma(o[0], fa, pa0, pa1, pa2, pa3); SBAR();
  v_reads<2>(fa, vb);
  asm volatile("s_waitcnt lgkmcnt(8)" ::: "memory"); SBAR(); pv_mma(o[1], fb, pa0, pa1, pa2, pa3); SBAR();
  v_reads<3>(fb, vb);
  asm volatile("s_waitcnt lgkmcnt(8)" ::: "memory"); SBAR(); pv_mma(o[2], fa, pa0, pa1, pa2, pa3); SBAR();
  asm volatile("s_waitcnt lgkmcnt(0)" ::: "memory"); SBAR(); pv_mma(o[3], fb, pa0, pa1, pa2, pa3);
}

template <int OFF> __device__ __forceinline__ bf16x8 lds_read16(int addr) { bf16x8 r; asm volatile("ds_read_b128 %0, %1 offset:%2" : "=&v"(r) : "v"(addr), "i"(OFF) : "memory"); return r; }
template <int D, int HALF> __device__ __forceinline__ bf16x8 kread(const int (&kbs)[8], const int (&krbs)[4]) {
  if constexpr (D < 8) return lds_read16<HALF * 8192>(kbs[D]); else return lds_read16<HALF * 4096>(krbs[D - 8]);
}
#define LGKM(n) asm volatile("s_waitcnt lgkmcnt(" #n ")" ::: "memory")
template <int ND0, int D> struct KStep {
  static __device__ __forceinline__ void run(f32x16& p0, f32x16& p1, bf16x8 (&kf0)[4], bf16x8 (&kf1)[4], const int (&kbs)[8], const int (&krbs)[4], const bf16x8* qr, VFrag& fa, int vb) {
    constexpr int R = (ND0 - 1 - D) < 3 ? (ND0 - 1 - D) : 3;
    constexpr bool VIN = D >= ND0 - 3;
    constexpr int CNT = 2 * R + (VIN ? 8 : 0);
    if constexpr (CNT == 6) LGKM(6); else if constexpr (CNT == 12) LGKM(12); else if constexpr (CNT == 10) LGKM(10); else LGKM(8);
    SBAR();
    p0 = __builtin_amdgcn_mfma_f32_32x32x16_bf16(kf0[D & 3], qr[D], p0, 0, 0, 0);
    p1 = __builtin_amdgcn_mfma_f32_32x32x16_bf16(kf1[D & 3], qr[D], p1, 0, 0, 0);
    SBAR();
    if constexpr (D + 4 < ND0) { kf0[D & 3] = kread<D + 4, 0>(kbs, krbs); kf1[D & 3] = kread<D + 4, 1>(kbs, krbs); }
    if constexpr (D == ND0 - 4) v_reads<0>(fa, vb);
    if constexpr (D + 1 < ND0) KStep<ND0, D + 1>::run(p0, p1, kf0, kf1, kbs, krbs, qr, fa, vb);
  }
};
template <int ND0> __device__ __forceinline__ void x_phase(f32x16& p0, f32x16& p1, f32x16* o, const int (&kbs)[8], const int (&krbs)[4], const bf16x8* qr, int vb, bool do_pv,
                                                           bf16x8 pa0, bf16x8 pa1, bf16x8 pa2, bf16x8 pa3) {
  static_assert(ND0 == 8 || ND0 == 12, "window arithmetic written for 8 or 12 k-steps");
  bf16x8 kf0[4], kf1[4]; VFrag fa, fb;
  p0 = f32x16{}; p1 = f32x16{};
  kf0[0] = kread<0, 0>(kbs, krbs); kf1[0] = kread<0, 1>(kbs, krbs); kf0[1] = kread<1, 0>(kbs, krbs); kf1[1] = kread<1, 1>(kbs, krbs);
  kf0[2] = kread<2, 0>(kbs, krbs); kf1[2] = kread<2, 1>(kbs, krbs); kf0[3] = kread<3, 0>(kbs, krbs); kf1[3] = kread<3, 1>(kbs, krbs);
  KStep<ND0, 0>::run(p0, p1, kf0, kf1, kbs, krbs, qr, fa, vb);
  v_reads<1>(fb, vb);
  LGKM(8); SBAR(); if (do_pv) pv_mma(o[0], fa, pa0, pa1, pa2, pa3); SBAR();
  v_reads<2>(fa, vb);
  LGKM(8); SBAR(); if (do_pv) pv_mma(o[1], fb, pa0, pa1, pa2, pa3); SBAR();
  v_reads<3>(fb, vb);
  LGKM(8); SBAR(); if (do_pv) pv_mma(o[2], fa, pa0, pa1, pa2, pa3); SBAR();
  LGKM(0); SBAR(); if (do_pv) pv_mma(o[3], fb, pa0, pa1, pa2, pa3); SBAR();
}
typedef int v8i_a __attribute__((ext_vector_type(8))); typedef int v4i_a __attribute__((ext_vector_type(4)));
#define CAT8A(x, y) __builtin_shufflevector(__builtin_bit_cast(v4i_a, x), __builtin_bit_cast(v4i_a, y), 0, 1, 2, 3, 4, 5, 6, 7)
struct KFrag8 { bf16x8 a0l, a0h, a1l, a1h; };
template <int KB> __device__ __forceinline__ void k8_reads(KFrag8& f, const int (&k8b)[2][2], const int (&kr8b)[2]) {
  if constexpr (KB < 2) { f.a0l = lds_read16<0>(k8b[KB][0]); f.a0h = lds_read16<0>(k8b[KB][1]); f.a1l = lds_read16<4096>(k8b[KB][0]); f.a1h = lds_read16<4096>(k8b[KB][1]); }
  else { f.a0l = lds_read16<0>(kr8b[0]); f.a0h = lds_read16<0>(kr8b[1]); f.a1l = lds_read16<2048>(kr8b[0]); f.a1h = lds_read16<2048>(kr8b[1]); }
}
template <bool NOMMA = false> __device__ __forceinline__ void k8_mma(f32x16& p0, f32x16& p1, const KFrag8& f, v8i_a q) {
  if constexpr (NOMMA) { asm volatile("" :: "v"(f.a0l), "v"(f.a0h), "v"(f.a1l), "v"(f.a1h)); return; }
  p0 = __builtin_amdgcn_mfma_scale_f32_32x32x64_f8f6f4(CAT8A(f.a0l, f.a0h), q, p0, 0, 0, 0, 0, 0, 0);
  p1 = __builtin_amdgcn_mfma_scale_f32_32x32x64_f8f6f4(CAT8A(f.a1l, f.a1h), q, p1, 0, 0, 0, 0, 0, 0);
}
struct VFrag8 { bf16x8 lo, hi_; };
template <int D0> __device__ __forceinline__ void vt_reads(VFrag8& f, const int (&vtb)[2]) { f.lo = lds_read16<D0 * 2048>(vtb[0]); f.hi_ = lds_read16<D0 * 2048>(vtb[1]); }
template <bool NOMMA = false> __device__ __forceinline__ void x_phase8(f32x16& p0, f32x16& p1, f32x16* o, const int (&k8b)[2][2], const int (&kr8b)[2], const v8i_a (&q8)[3], const int (&vtb)[2], bool do_pv, v8i_a pa8) {
  KFrag8 ka, kb; VFrag8 va, vb_;
  p0 = f32x16{}; p1 = f32x16{};
  k8_reads<0>(ka, k8b, kr8b); k8_reads<1>(kb, k8b, kr8b);
  LGKM(4); SBAR(); k8_mma<NOMMA>(p0, p1, ka, q8[0]); SBAR();
  k8_reads<2>(ka, k8b, kr8b);
  LGKM(4); SBAR(); k8_mma<NOMMA>(p0, p1, kb, q8[1]); SBAR();
  vt_reads<0>(va, vtb); vt_reads<1>(vb_, vtb);
  LGKM(4); SBAR(); k8_mma<NOMMA>(p0, p1, ka, q8[2]); SBAR();
  LGKM(2); SBAR(); if constexpr (NOMMA) asm volatile("" :: "v"(va.lo), "v"(va.hi_)); else if (do_pv) o[0] = __builtin_amdgcn_mfma_scale_f32_32x32x64_f8f6f4(pa8, CAT8A(va.lo, va.hi_), o[0], 0, 0, 0, 0, 0, 0); SBAR();
  vt_reads<2>(va, vtb);
  LGKM(2); SBAR(); if constexpr (NOMMA) asm volatile("" :: "v"(vb_.lo), "v"(vb_.hi_)); else if (do_pv) o[1] = __builtin_amdgcn_mfma_scale_f32_32x32x64_f8f6f4(pa8, CAT8A(vb_.lo, vb_.hi_), o[1], 0, 0, 0, 0, 0, 0); SBAR();
  vt_reads<3>(vb_, vtb);
  LGKM(2); SBAR(); if constexpr (NOMMA) asm volatile("" :: "v"(va.lo), "v"(va.hi_)); else if (do_pv) o[2] = __builtin_amdgcn_mfma_scale_f32_32x32x64_f8f6f4(pa8, CAT8A(va.lo, va.hi_), o[2], 0, 0, 0, 0, 0, 0); SBAR();
  LGKM(0); SBAR(); if constexpr (NOMMA) asm volatile("" :: "v"(vb_.lo), "v"(vb_.hi_)); else if (do_pv) o[3] = __builtin_amdgcn_mfma_scale_f32_32x32x64_f8f6f4(pa8, CAT8A(vb_.lo, vb_.hi_), o[3], 0, 0, 0, 0, 0, 0); SBAR();
}
template <bool NOMMA = false, bool NOWAIT = false> __device__ __forceinline__ void x8_a(f32x16& p0, f32x16& p1, KFrag8& ka, KFrag8& kb, const int (&k8b)[2][2], const int (&kr8b)[2], const v8i_a (&q8)[3], VFrag8& v0, const int (&vtb)[2]) {
  p0 = f32x16{}; p1 = f32x16{};
  k8_reads<0>(ka, k8b, kr8b); k8_reads<1>(kb, k8b, kr8b);
  if constexpr (!NOWAIT) LGKM(4); SBAR(); k8_mma<NOMMA>(p0, p1, ka, q8[0]); SBAR();
  k8_reads<2>(ka, k8b, kr8b); vt_reads<0>(v0, vtb);
}
template <bool NOMMA = false, bool NOWAIT = false> __device__ __forceinline__ void x8_b(f32x16& p0, f32x16& p1, const KFrag8& kb, const v8i_a (&q8)[3], VFrag8& v1, VFrag8& v2, const int (&vtb)[2]) {
  if constexpr (!NOWAIT) LGKM(6); SBAR(); k8_mma<NOMMA>(p0, p1, kb, q8[1]); SBAR();
  vt_reads<1>(v1, vtb); vt_reads<2>(v2, vtb);
}
template <bool NOMMA = false, bool NOPV = false, bool NOWAIT = false> __device__ __forceinline__ void x8_c(f32x16& p0, f32x16& p1, f32x16* o, const KFrag8& ka, const v8i_a (&q8)[3], const VFrag8& v0, const VFrag8& v1, const VFrag8& v2, VFrag8& v3, const int (&vtb)[2], bool do_pv, v8i_a pa8) {
  if constexpr (!NOWAIT) LGKM(6); SBAR(); k8_mma<NOMMA>(p0, p1, ka, q8[2]); SBAR();
  vt_reads<3>(v3, vtb);
#define PV8(I, V, CNT) if constexpr (!NOWAIT) LGKM(CNT); SBAR(); if constexpr (NOMMA || NOPV) asm volatile("" :: "v"(V.lo), "v"(V.hi_)); else if (do_pv) o[I] = __builtin_amdgcn_mfma_scale_f32_32x32x64_f8f6f4(pa8, CAT8A(V.lo, V.hi_), o[I], 0, 0, 0, 0, 0, 0); else asm volatile("" :: "v"(V.lo), "v"(V.hi_)); SBAR();
  PV8(0, v0, 6) PV8(1, v1, 4) PV8(2, v2, 2) PV8(3, v3, 0)
#undef PV8
}
__device__ __forceinline__ void pv8_tail(f32x16* o, const int (&vtb)[2], v8i_a pa8) {
  VFrag8 va, vb_;
  vt_reads<0>(va, vtb); vt_reads<1>(vb_, vtb);
  LGKM(2); SBAR(); o[0] = __builtin_amdgcn_mfma_scale_f32_32x32x64_f8f6f4(pa8, CAT8A(va.lo, va.hi_), o[0], 0, 0, 0, 0, 0, 0); SBAR();
  vt_reads<2>(va, vtb);
  LGKM(2); SBAR(); o[1] = __builtin_amdgcn_mfma_scale_f32_32x32x64_f8f6f4(pa8, CAT8A(vb_.lo, vb_.hi_), o[1], 0, 0, 0, 0, 0, 0); SBAR();
  vt_reads<3>(vb_, vtb);
  LGKM(2); SBAR(); o[2] = __builtin_amdgcn_mfma_scale_f32_32x32x64_f8f6f4(pa8, CAT8A(va.lo, va.hi_), o[2], 0, 0, 0, 0, 0, 0); SBAR();
  LGKM(0); SBAR(); o[3] = __builtin_amdgcn_mfma_scale_f32_32x32x64_f8f6f4(pa8, CAT8A(vb_.lo, vb_.hi_), o[3], 0, 0, 0, 0, 0, 0); SBAR();
}
template <bool NOEXP = false> __device__ __forceinline__ void finishSM8(f32x16& p0, f32x16& p1, float alpha, float& l_reg, v8i_a& pa8) {
#pragma unroll
  for (int r = 0; r < 16; ++r) p1[r] = NOEXP ? p1[r] : __builtin_amdgcn_exp2f(p1[r]);
  float ps = 0;
#pragma unroll
  for (int r = 0; r < 16; ++r) ps += p0[r];
#pragma unroll
  for (int r = 0; r < 16; ++r) ps += p1[r];
  { auto rr = __builtin_amdgcn_permlane32_swap(__float_as_uint(ps), __float_as_uint(ps), false, false);
    ps = __uint_as_float(rr[0]) + __uint_as_float(rr[1]); }
  l_reg = l_reg * alpha + ps;
#pragma unroll
  for (int g = 0; g < 4; ++g) {
    int d0 = __builtin_amdgcn_cvt_pk_fp8_f32(p0[4 * g], p0[4 * g + 1], 0, false); d0 = __builtin_amdgcn_cvt_pk_fp8_f32(p0[4 * g + 2], p0[4 * g + 3], d0, true);
    int d1 = __builtin_amdgcn_cvt_pk_fp8_f32(p1[4 * g], p1[4 * g + 1], 0, false); d1 = __builtin_amdgcn_cvt_pk_fp8_f32(p1[4 * g + 2], p1[4 * g + 3], d1, true);
    auto sw = __builtin_amdgcn_permlane32_swap((unsigned)d0, (unsigned)d1, false, false);
    pa8[2 * g] = (int)sw[0]; pa8[2 * g + 1] = (int)sw[1]; }
}
#undef CAT8A
#undef LGKM

struct UnitArgs {
  const bf16* Q;
  const bf16* K; const bf16* V;
  const bf16* KR;
  unsigned char* O;
  int NT, seg0_tiles, seg0_row, seg1_row;
  float C;
  const float* rpb;
  int lo_row, r0;
};

template <int MODE, int VAR = 0>
__device__ __forceinline__ void attn_unit(const UnitArgs& A, __attribute__((address_space(3))) unsigned char* ldsl, const int wid0) {
  typedef __attribute__((address_space(3))) unsigned LU;
  constexpr bool F8 = (MODE == 2);
  constexpr int ND0 = 8, LDQ = F8 ? 3072 : 1024, LDK = F8 ? 2048 : 1024, LDO = 2048;
  char* lds = (char*)ldsl;
  int wid_ = wid0; asm volatile("" : "+s"(wid_));
  const int wid = wid_, lane = hw_lane(), tid = wid * 64 + lane, r32 = lane & 31, hi = lane >> 5;
  char* V_lds = lds + OFF_V; char* K_lds = lds + OFF_K; char* KR_lds = lds + OFF_KR;
  float* wsf = (float*)(lds + OFF_WS) + wid * 64; float* li_l = wsf; float* al_l = wsf + 32;
  float* rpbL = (float*)(lds + OFF_RPB);
  float m_reg = -1e30f, l_reg = 0; f32x16 o[4] = {}; bf16x8 qr[ND0];
  v8i_a q8[3];
  if constexpr (F8) { const unsigned char* Qb = (const unsigned char*)A.Q + (long)(wid * QBLK + r32) * LDQ + hi * 32;
#pragma unroll
    for (int kbk = 0; kbk < 3; ++kbk) q8[kbk] = *reinterpret_cast<const v8i_a*>(Qb + kbk * 64); }
  else { const bf16* Qw = A.Q + (long)(wid * QBLK + r32) * LDQ + hi * 8;
#pragma unroll
    for (int d0 = 0; d0 < ND0; ++d0) qr[d0] = *reinterpret_cast<const bf16x8*>(Qw + d0 * 16); }
  if constexpr (MODE == 1) { if (A.rpb && tid < 465) rpbL[tid] = A.rpb[tid] * 1.4426950408889634f; }
  int koff[2], voff[2], kroff = 0;
#pragma unroll
  for (int i = 0; i < 2; ++i) { const int ob = (wid * 2 + i) * 1024 + lane * 16;
    { const int row = ob >> 8, w = ob & 255, cb = w ^ ((row & 15) << 4); koff[i] = row * LDK + (cb >> 1); }
    { const int sub = ob >> 9, within = ob & 511, kk = (sub >> 2) * 8 + (within >> 6), k = (kk & ~0xC) | ((kk & 4) << 1) | ((kk & 8) >> 1), col = (sub & 3) * 32 + ((within & 63) >> 1); voff[i] = k * LDK + col; } }
  int vtoff = 0;
  if constexpr (F8) { const int ob = wid * 1024 + lane * 16, d = ob >> 6, ch = ((ob & 63) >> 4) ^ ((d >> 2) & 3); vtoff = d * VT_PITCH + ch * 16; }
  int k8off = 0;
  if constexpr (F8) { { const int ob = wid * 1024 + lane * 16, row = ob >> 7, ch = ((ob & 127) >> 4) ^ ((row >> 1) & 7); k8off = row * LDK + ch * 16; }
    { const int ob = (wid & 3) * 1024 + lane * 16, row = ob >> 6, ch = ((ob & 63) >> 4) ^ ((row >> 2) & 3); kroff = row * 64 + ch * 16; } }
  const int vb0 = (int)(uintptr_t)V_lds + v_rd_base(lane);
  int vtb0[2];
#pragma unroll
  for (int jj = 0; jj < 2; ++jj) vtb0[jj] = (int)(uintptr_t)V_lds + r32 * 64 + (((2 * hi + jj) ^ ((r32 >> 2) & 3)) << 4);
  int k8b0[2][2], kr8b0[2];
#pragma unroll
  for (int kbk = 0; kbk < 2; ++kbk)
#pragma unroll
    for (int jj = 0; jj < 2; ++jj) k8b0[kbk][jj] = (int)(uintptr_t)K_lds + r32 * 128 + (((4 * kbk + 2 * hi + jj) ^ ((r32 >> 1) & 7)) << 4);
#pragma unroll
  for (int jj = 0; jj < 2; ++jj) kr8b0[jj] = (int)(uintptr_t)KR_lds + r32 * 64 + (((2 * hi + jj) ^ ((r32 >> 2) & 3)) << 4);
  int kb[8], krb[4];
#pragma unroll
  for (int x = 0; x < 8; ++x) kb[x] = (int)(uintptr_t)K_lds + r32 * 256 + ((x * 32 + hi * 16) ^ ((r32 & 15) << 4));
#pragma unroll
  for (int x = 0; x < 4; ++x) krb[x] = (int)(uintptr_t)KR_lds + r32 * 128 + (((x * 2 + hi) ^ ((r32 >> 1) & 7)) << 4);
  const float C = A.C;
  int qc = 0, cs = 0, qrow = 0, rs = 0;
  if constexpr (MODE == 1) { qc = (wid & 1) * 32 + r32; cs = qc - 8; cs = cs < 0 ? 0 : (cs > 48 ? 48 : cs); qrow = A.r0 + (wid >> 1); rs = qrow - 4; rs = rs < 0 ? 0 : (rs > 56 ? 56 : rs); }
#define TROW(j) ((j) < A.seg0_tiles ? A.seg0_row + 64 * (j) : A.seg1_row + 64 * ((j) - A.seg0_tiles))
#define DMA16(gp, ldsoff) __builtin_amdgcn_global_load_lds((const unsigned*)(gp), (LU*)(ldsl + (ldsoff)), 16, 0, 0)
#define ISSUE_K(j, slot) do { const long R0_ = TROW(j); if constexpr (F8) { DMA16((const unsigned char*)A.K + R0_ * LDK + k8off, OFF_K + (slot) * SHM_K + wid * 1024); \
      if (wid < 4) DMA16((const unsigned char*)A.KR + R0_ * 64 + kroff, OFF_KR + (slot) * SHM_KR + wid * 1024); } else { const bf16* kb_ = A.K + R0_ * LDK; \
    DMA16(kb_ + koff[0], OFF_K + (slot) * SHM_K + (wid * 2) * 1024); DMA16(kb_ + koff[1], OFF_K + (slot) * SHM_K + (wid * 2 + 1) * 1024); } } while (0)
#define ISSUE_K2(j, slot) do { const long R0_ = TROW(j); if constexpr (F8) { const unsigned char* k8_ = (const unsigned char*)A.K + R0_ * LDK + k8off; \
      DMA16(k8_, OFF_K + (slot) * SHM_K + wid * 1024); DMA16(k8_ + 32 * LDK, OFF_K + (slot) * SHM_K + (wid + 4) * 1024); \
      DMA16((const unsigned char*)A.KR + R0_ * 64 + kroff, OFF_KR + (slot) * SHM_KR + wid * 1024); } else { const bf16* kb_ = A.K + R0_ * LDK; const bf16* kb2_ = kb_ + 32 * LDK; \
    DMA16(kb_ + koff[0], OFF_K + (slot) * SHM_K + (wid * 2) * 1024); DMA16(kb_ + koff[1], OFF_K + (slot) * SHM_K + (wid * 2 + 1) * 1024); \
    DMA16(kb2_ + koff[0], OFF_K + (slot) * SHM_K + (wid * 2 + 8) * 1024); DMA16(kb2_ + koff[1], OFF_K + (slot) * SHM_K + (wid * 2 + 9) * 1024); } } while (0)
#define ISSUE_V(j, slot) do { const long R0_ = TROW(j); if constexpr (F8) { DMA16((const unsigned char*)A.V + R0_ + vtoff, OFF_V + (slot) * SHM_V + wid * 1024); } else { const bf16* vb_ = A.V + R0_ * LDK; \
    DMA16(vb_ + voff[0], OFF_V + (slot) * SHM_V + (wid * 2) * 1024); DMA16(vb_ + voff[1], OFF_V + (slot) * SHM_V + (wid * 2 + 1) * 1024); } } while (0)
#define ISSUE_V2(j, slot) do { const long R0_ = TROW(j); if constexpr (F8) { const unsigned char* vt_ = (const unsigned char*)A.V + R0_ + vtoff; \
      DMA16(vt_, OFF_V + (slot) * SHM_V + wid * 1024); DMA16(vt_ + 64 * (long)VT_PITCH, OFF_V + (slot) * SHM_V + (wid + 4) * 1024); } else { const bf16* vb_ = A.V + R0_ * LDK; const bf16* vb2_ = vb_ + 32 * LDK; \
    DMA16(vb_ + voff[0], OFF_V + (slot) * SHM_V + (wid * 2) * 1024); DMA16(vb_ + voff[1], OFF_V + (slot) * SHM_V + (wid * 2 + 1) * 1024); \
    DMA16(vb2_ + voff[0], OFF_V + (slot) * SHM_V + (wid * 2 + 8) * 1024); DMA16(vb2_ + voff[1], OFF_V + (slot) * SHM_V + (wid * 2 + 9) * 1024); } } while (0)
#define RESC(a) do { if (__any((a) < 1.f)) { if (hi == 0) al_l[r32] = (a); asm volatile("s_waitcnt lgkmcnt(0)" ::: "memory"); \
    _Pragma("unroll") for (int d = 0; d < 4; ++d) _Pragma("unroll") for (int r = 0; r < 16; ++r) o[d][r] *= al_l[crow(r, hi)]; } } while (0)
#define BM_HALF(P, OFS) do { _Pragma("unroll") for (int g_ = 0; g_ < 4; ++g_) { _Pragma("unroll") for (int rr_ = 0; rr_ < 4; ++rr_) { const int r = 4 * g_ + rr_, k0_ = 8 * g_ + rr_ + (OFS); \
      P[r] = ((unsigned)(k0_ + kd_) < 16u) ? fmaf(P[r], C, bp_[k0_]) : -1e30f; } asm volatile("" ::: "memory"); } } while (0)
#define BIASMASK(P0, P1, j) do { if constexpr (MODE == 1) { \
    if ((j) < 4) { _Pragma("unroll") for (int r = 0; r < 16; ++r) { P0[r] *= C; P1[r] *= C; } } \
    else { const int kr_ = A.lo_row + (j) - 4, dr_ = kr_ - qrow; const bool rowok_ = (unsigned)(kr_ - rs) < 8u; \
      if (!rowok_) { _Pragma("unroll") for (int r = 0; r < 16; ++r) { P0[r] = -1e30f; P1[r] = -1e30f; } } \
      else { const float* bp_ = rpbL + (dr_ + 7) * 31 + 15 - qc + 4 * hi; const int kd_ = 4 * hi - cs; BM_HALF(P0, 0); BM_HALF(P1, 32); } } } } while (0)
  constexpr bool PRE = (MODE == 1);
  const bool grpB = wid >= 4;
  f32x16 p0, p1; float mn = 0.f, al = 1.f; bf16x8 pa0, pa1, pa2, pa3; const int NT = A.NT;
  pa0 = pa1 = pa2 = pa3 = bf16x8{}; v8i_a pa8 = {};
#define WAITG(nk_exists, nv_exists) do { if (nk_exists) { if constexpr (F8) asm volatile("s_waitcnt vmcnt(5) lgkmcnt(0)" ::: "memory"); else asm volatile("s_waitcnt vmcnt(8) lgkmcnt(0)" ::: "memory"); } \
    else if (nv_exists) { if constexpr (F8) asm volatile("s_waitcnt vmcnt(2) lgkmcnt(0)" ::: "memory"); else asm volatile("s_waitcnt vmcnt(4) lgkmcnt(0)" ::: "memory"); } else asm volatile("s_waitcnt vmcnt(0) lgkmcnt(0)" ::: "memory"); \
    __builtin_amdgcn_s_barrier(); asm volatile("" ::: "memory"); } while (0)
  ISSUE_K(0, 0); ISSUE_V(0, 0); ISSUE_K(1, 1);
  asm volatile("s_waitcnt vmcnt(0) lgkmcnt(0)" ::: "memory");
  if constexpr (F8) { asm volatile("" : "+v"(q8[0]), "+v"(q8[1]), "+v"(q8[2])); } else {
#pragma unroll
  for (int d0 = 0; d0 < ND0; ++d0) asm volatile("" : "+v"(qr[d0])); }
  __builtin_amdgcn_s_barrier(); asm volatile("" ::: "memory");
  if (grpB) { __builtin_amdgcn_s_barrier(); asm volatile("" ::: "memory"); }
  KFrag8 ka8, kb8;
  int sk = 0;
  for (int j = 0; j < NT; ++j) {
    const int s1_ = sk == 2 ? 0 : sk + 1, s2_ = sk == 0 ? 2 : sk - 1;
    if constexpr (F8) {
      if (grpB) { if (j + 1 < NT) asm volatile("s_waitcnt vmcnt(2)" ::: "memory"); else asm volatile("s_waitcnt vmcnt(1)" ::: "memory"); }
      __builtin_amdgcn_s_barrier(); asm volatile("" ::: "memory"); }
    else WAITG(j + 1 < NT, true);
    if constexpr (!F8) { if (!grpB) { if (j + 2 < NT) ISSUE_K2(j + 2, s2_); if (j + 1 < NT) ISSUE_V2(j + 1, s1_); } }
    if constexpr (F8) { const int kr8b[2] = {kr8b0[0] + sk * SHM_KR, kr8b0[1] + sk * SHM_KR};
      const int k8b[2][2] = {{k8b0[0][0] + sk * SHM_K, k8b0[0][1] + sk * SHM_K}, {k8b0[1][0] + sk * SHM_K, k8b0[1][1] + sk * SHM_K}};
      const int vtb[2] = {vtb0[0] + s2_ * SHM_V, vtb0[1] + s2_ * SHM_V};
      VFrag8 v0, v1, v2, v3;
      SBAR(); __builtin_amdgcn_s_setprio(1);
      if constexpr (VAR != 8) x8_a<VAR == 2 || VAR == 5 || VAR == 7, VAR == 9>(p0, p1, ka8, kb8, k8b, kr8b, q8, v0, vtb);
      SBAR(); if (VAR != 7) { if (j + 2 < NT) ISSUE_K(j + 2, s2_); } SBAR();
      if constexpr (VAR != 8) x8_b<VAR == 2 || VAR == 5 || VAR == 7, VAR == 9>(p0, p1, kb8, q8, v1, v2, vtb);
      SBAR(); if (VAR != 7) { if (j + 1 < NT) ISSUE_V(j + 1, s1_); } SBAR();
      if constexpr (VAR != 8) x8_c<VAR == 2 || VAR == 5 || VAR == 7, VAR == 6, VAR == 9>(p0, p1, o, ka8, q8, v0, v1, v2, v3, vtb, j > 0, pa8);
      __builtin_amdgcn_s_setprio(0); }
    else { int kbs[8], krbs[4];
#pragma unroll
      for (int x = 0; x < 8; ++x) kbs[x] = kb[x] + sk * SHM_K;
#pragma unroll
      for (int x = 0; x < 4; ++x) krbs[x] = krb[x] + sk * SHM_KR;
      SBAR(); __builtin_amdgcn_s_setprio(1); x_phase<ND0>(p0, p1, o, kbs, krbs, qr, vb0 + s2_ * SHM_V, j > 0, pa0, pa1, pa2, pa3); __builtin_amdgcn_s_setprio(0); }
    SBAR();
    if constexpr (F8) {
      if (grpB) asm volatile("s_waitcnt lgkmcnt(0)" ::: "memory"); else if (j + 1 >= NT) asm volatile("s_waitcnt vmcnt(0) lgkmcnt(0)" ::: "memory"); else if (j + 2 < NT) asm volatile("s_waitcnt vmcnt(3) lgkmcnt(0)" ::: "memory"); else asm volatile("s_waitcnt vmcnt(1) lgkmcnt(0)" ::: "memory");
      __builtin_amdgcn_s_barrier(); asm volatile("" ::: "memory"); }
    else WAITG(j + 2 < NT, j + 1 < NT);
    if constexpr (VAR != 3 && VAR < 5) { BIASMASK(p0, p1, j); partialSM<PRE, F8, VAR == 1>(p0, p1, m_reg, mn, al, C); RESC(al);
    if constexpr (F8) finishSM8<VAR == 1>(p0, p1, al, l_reg, pa8); else finishSM(p0, p1, al, l_reg, pa0, pa1, pa2, pa3); }
    else { asm volatile("" : "+v"(p0), "+v"(p1)); }
    sk = s1_;
  }
  asm volatile("s_waitcnt vmcnt(0) lgkmcnt(0)" ::: "memory"); __builtin_amdgcn_s_barrier(); asm volatile("" ::: "memory");
  { const int s2_ = sk == 0 ? 2 : sk - 1; SBAR(); if constexpr (F8) { const int vtb[2] = {vtb0[0] + s2_ * SHM_V, vtb0[1] + s2_ * SHM_V}; pv8_tail(o, vtb, pa8); } else pv_d0(o, vb0 + s2_ * SHM_V, pa0, pa1, pa2, pa3); }
  if (!grpB) { __builtin_amdgcn_s_barrier(); asm volatile("" ::: "memory"); }
#undef WAITG
  if (hi == 0) li_l[r32] = l_reg; asm volatile("s_waitcnt lgkmcnt(0)" ::: "memory");
  unsigned char* Ow = A.O + (long)(wid * QBLK) * LDO;
  const bool pb = (lane & 1) != 0, sb = (lane & 2) != 0;
#pragma unroll
  for (int g = 0; g < 4; ++g) {
    float inv[4];
#pragma unroll
    for (int i = 0; i < 4; ++i) inv[i] = __builtin_amdgcn_rcpf(li_l[crow(4 * g + i, hi)]) * O_SCALE;
#pragma unroll
    for (int d0 = 0; d0 < 4; ++d0) {
      const float a0 = o[d0][4 * g] * inv[0], a1 = o[d0][4 * g + 1] * inv[1], a2 = o[d0][4 * g + 2] * inv[2], a3 = o[d0][4 * g + 3] * inv[3];
      const float r0 = shfl_xor_c<1>(pb ? a0 : a1), r1 = shfl_xor_c<1>(pb ? a2 : a3);
      const float c00 = pb ? r0 : a0, c01 = pb ? a1 : r0, c10 = pb ? r1 : a2, c11 = pb ? a3 : r1;
      const float t0 = shfl_xor_c<2>(sb ? c00 : c10), t1 = shfl_xor_c<2>(sb ? c01 : c11);
      const float m0 = sb ? c10 : c00, m1 = sb ? c11 : c01;
      const float b0 = sb ? t0 : m0, b1 = sb ? t1 : m1, b2 = sb ? m0 : t0, b3 = sb ? m1 : t1;
      *reinterpret_cast<unsigned*>(Ow + (long)((lane & 3) + 8 * g + 4 * hi) * LDO + d0 * 32 + (r32 & ~3)) = pg8::pk4_fp8(b0, b1, b2, b3); } }
  asm volatile("s_waitcnt vmcnt(0) lgkmcnt(0)" ::: "memory"); __builtin_amdgcn_s_barrier(); asm volatile("" ::: "memory");
#undef TROW
#undef DMA16
#undef ISSUE_K
#undef ISSUE_V
#undef ISSUE_K2
#undef ISSUE_V2
#undef RESC
#undef BIASMASK
#undef BM_HALF
}
#undef KSWZ
#undef KRSWZ
#undef SBAR
}

constexpr int NWAVES = 8;
constexpr int DM = 2048, DFF = 5632, MCTX = 4096, MLAT = 32768, MTOK = MCTX + MLAT  , MCACHE = 2048, MKV = MTOK + MCACHE  ;
constexpr int NCOND = 9, NMODC = 9 * DM  ;
constexpr float ALPHA = 1.4142135623730951f, LN_EPS = 1e-5f, RMS_EPS = 1e-6f;
constexpr int NDOWN = 1280;
enum { I_XP = 0, I_XS, I_CNK, I_CNV, I_CCKV, I_CKPE, I_C, I_CCTX, I_WMOD, I_BMOD, I_LNG, I_LNB, I_W1, I_W3, I_W2, I_WIN, I_WMIXO, I_RPB, I_POOLW, I_POOLS, I_WDOWN, I_QNORM, I_WUQ, I_KVNORM, I_WUKV, I_WOUT, N_IN };
constexpr size_t OUT_Y = 0, OUT_NAK = (size_t)MTOK * DM, OUT_NAV = OUT_NAK + (size_t)MCTX * 1024, OUT_CKV = OUT_NAV + (size_t)MCTX * 1024, OUT_KPE = OUT_CKV + (size_t)MCTX * 512, OUT_END = OUT_KPE + (size_t)MCTX * 64;
constexpr size_t MiB = 1u << 20;
constexpr size_t al256(size_t x) { return (x + 255) / 256 * 256; }
constexpr size_t WS_CTL = 0, CTL_ZERO_BYTES = 1 * MiB;
constexpr size_t WS_MOD = 1 * MiB;
constexpr size_t WS_ROPE = WS_MOD + al256((size_t)NCOND * 2 * NMODC * 4);
constexpr size_t WS_ST = WS_ROPE + 8192;
constexpr size_t WS_IDLN = WS_ST + al256((size_t)MTOK * 8);
constexpr size_t WS_AB = WS_IDLN + 16384;
constexpr size_t WS_W13 = WS_AB + al256((size_t)NCOND * 6 * 2 * DM * 4);
constexpr size_t SZ_W13 = (size_t)2 * DFF * DM, SZ_W2 = (size_t)DM * DFF;
constexpr size_t WS_W2 = WS_W13 + 4 * SZ_W13;
constexpr size_t WS_WIN = WS_W2 + 4 * SZ_W2;
constexpr size_t WS_WMIX = WS_WIN + (size_t)4096 * DM * 2;
constexpr size_t WS_WDOWN = WS_WMIX + (size_t)DM * DM * 2;
constexpr size_t WS_WUQ = WS_WDOWN + (size_t)NDOWN * DM * 2;
constexpr size_t WS_WUKV = WS_WUQ + (size_t)3072 * 512 * 2;
constexpr size_t WS_WOUT = WS_WUKV + (size_t)4096 * 512 * 2;
constexpr size_t WS_WIN8 = WS_WOUT + (size_t)DM * DM * 2;
constexpr size_t WS_WDOWN8 = WS_WIN8 + (size_t)4096 * DM;
constexpr size_t WS_H = WS_WDOWN8 + (size_t)NDOWN * DM;
constexpr size_t WS_T = WS_H + (size_t)MTOK * DM * 2;
constexpr size_t WS_S = WS_T + (size_t)MTOK * DM * 2;
constexpr size_t WS_G = WS_S;
constexpr size_t SZ_QKVU = (size_t)MKV * 1024 * 2;
constexpr size_t WS_EQ = WS_S, WS_CAT = WS_S + 4 * SZ_QKVU;
constexpr size_t WS_DOWN = WS_S, WS_MQ = WS_S;
constexpr size_t WS_CQ = WS_S + (size_t)MTOK * 3072 * 2;
constexpr size_t WS_CKV = WS_CQ + (size_t)MTOK * 512 * 2;
constexpr size_t WS_KPE = WS_CKV + (size_t)MKV * 512 * 2;
constexpr size_t WS_KV = WS_KPE + (size_t)MKV * 64 * 2;
constexpr size_t WS_END_ODD = WS_KV + (size_t)MKV * 4096 * 2, WS_END_EVEN = WS_CAT + (size_t)MTOK * DM * 2, WS_END_FFN = WS_G + (size_t)MTOK * DFF;
constexpr size_t WS_END = WS_END_ODD > WS_END_EVEN ? (WS_END_ODD > WS_END_FFN ? WS_END_ODD : WS_END_FFN) : (WS_END_EVEN > WS_END_FFN ? WS_END_EVEN : WS_END_FFN);
static_assert((size_t)MTOK * NDOWN * 4 <= (size_t)MTOK * 3072 * 2, "DOWN fits under Q");
constexpr int CW_BAR = 4096;
constexpr int MAX_LAUNCH = 32;
static_assert((CW_BAR + MAX_LAUNCH * 3456) * 4 <= (int)CTL_ZERO_BYTES, "CTL");
constexpr int RING_OFF = 0, RING_BYTES = 131072, LDSCTL_OFF = RING_BYTES, MISC_OFF = LDSCTL_OFF + 320, LDS_BYTES = 147456;

#define GAS __attribute__((address_space(1)))
#define LAS __attribute__((address_space(3)))
typedef unsigned short bf16;
typedef unsigned v4u __attribute__((ext_vector_type(4)));
typedef unsigned v2u __attribute__((ext_vector_type(2)));
typedef float f32x4 __attribute__((ext_vector_type(4)));
#define LDS_WAIT() asm volatile("s_waitcnt lgkmcnt(0)" ::: "memory")
#define VM_WAIT() asm volatile("s_waitcnt vmcnt(0)" ::: "memory")
__device__ __forceinline__ unsigned f2bf(float f) { unsigned u = __builtin_bit_cast(unsigned, f); return (u + 0x7fffu + ((u >> 16) & 1u)) >> 16; }
__device__ __forceinline__ unsigned pk2(float lo, float hi) { return f2bf(lo) | (f2bf(hi) << 16); }
__device__ __forceinline__ float bf2f(unsigned short b) { return __builtin_bit_cast(float, (unsigned)b << 16); }
#define XB_TMO      128
#define XB_XCNT(j)  (256  + 64 * (j))
#define XB_XSUB(j)  (1280 + 64 * (j))
#define XB_XGEN(j)  (2304 + 64 * (j))
#define XB_TOP      3328
#define XB_TOPGEN   3392
#define XCD_BAR_WORDS 3456
#define XB_SPIN_CAP (1u << 18)

__device__ __forceinline__ unsigned xb_ld(unsigned* p)              { return __hip_atomic_load(p, __ATOMIC_RELAXED, __HIP_MEMORY_SCOPE_AGENT); }
__device__ __forceinline__ unsigned xb_add(unsigned* p, unsigned v) { return __hip_atomic_fetch_add(p, v, __ATOMIC_RELAXED, __HIP_MEMORY_SCOPE_AGENT); }
__device__ __forceinline__ unsigned xb_xcc_id() { return (unsigned)__builtin_amdgcn_s_getreg((3 << 11) | 20) & 0xFu; }
#define XB_SPIN(cond, bar) do { unsigned _sp = 0; while (cond) { __builtin_amdgcn_s_sleep(1); \
    if ((++_sp & 255u) == 0u) { if (xb_ld(&(bar)[XB_TMO])) break; if (_sp > XB_SPIN_CAP) { atomicAdd(&(bar)[XB_TMO], 1u); break; } } } } while (0)

struct XcdBarrier {
    unsigned* bar; unsigned x; int wid0;
    volatile LAS unsigned* st;
};

__device__ __forceinline__ XcdBarrier xcd_barrier_post(unsigned* bar, volatile LAS unsigned* st, int wid0) {
    XcdBarrier b; b.bar = bar; b.x = xb_xcc_id(); b.st = st; b.wid0 = wid0;
    if (wid0 == 0 && hw_lane() == 0) (void)xb_add(&bar[XB_XCNT(b.x)], 1u);
    return b;
}
__device__ __forceinline__ void xcd_barrier_complete(unsigned* bar, unsigned x, unsigned& nloc, unsigned& nx) {
    const unsigned G = gridDim.x * gridDim.y * gridDim.z;
    unsigned sum, cnt, mine, sp = 0u;
    for (;;) {
        sum = 0u; cnt = 0u; mine = 0u;
#pragma unroll
        for (unsigned j = 0; j < 16; ++j) { const unsigned c = xb_ld(&bar[XB_XCNT(j)]); sum += c; cnt += (c > 0u) ? 1u : 0u; mine = (j == x) ? c : mine; }
        if (sum == G) break;
        __builtin_amdgcn_s_sleep(1);
        if ((++sp & 255u) == 0u) { if (xb_ld(&bar[XB_TMO])) break; if (sp > XB_SPIN_CAP) { atomicAdd(&bar[XB_TMO], 1u); break; } }
    }
    nloc = mine > 0u ? mine : 1u; nx = cnt > 0u ? cnt : 1u;
}

__device__ __forceinline__ void xcd_barrier(const XcdBarrier& b) {
    asm volatile("s_waitcnt vmcnt(0)" ::: "memory");
    __syncthreads();
    if (b.wid0 == 0 && hw_lane() == 0) {
        unsigned* bar = b.bar;
        __builtin_amdgcn_s_waitcnt(0);
        unsigned nloc = b.st[0], nx = b.st[1];
        if (nloc == 0u) { xcd_barrier_complete(bar, b.x, nloc, nx); b.st[0] = nloc; b.st[1] = nx; }
        const unsigned old = xb_add(&bar[XB_XSUB(b.x)], 1u);
        const unsigned gen = old / nloc;
        if (old + 1u == (gen + 1u) * nloc) {
            __builtin_amdgcn_fence(__ATOMIC_RELEASE, "agent");
            asm volatile("s_waitcnt vmcnt(0)" ::: "memory");
            const unsigned og = xb_add(&bar[XB_TOP], 1u);
            const unsigned tg = og / nx;
            if (og + 1u == (tg + 1u) * nx) xb_add(&bar[XB_TOPGEN], 1u);
            else XB_SPIN(xb_ld(&bar[XB_TOPGEN]) == tg, bar);
            __builtin_amdgcn_fence(__ATOMIC_ACQUIRE, "agent");
            xb_add(&bar[XB_XGEN(b.x)], 1u);
            asm volatile("s_waitcnt vmcnt(0)" ::: "memory");
        } else {
            XB_SPIN(xb_ld(&bar[XB_XGEN(b.x)]) == gen, bar);
            __builtin_amdgcn_fence(__ATOMIC_ACQUIRE, "agent");
            asm volatile("s_waitcnt vmcnt(0)" ::: "memory");
        }
    }
    __syncthreads();
}
struct Args { const float* in[N_IN]; float* out; unsigned char* ws; int ph_lo, ph_hi, li, pad; };
#define CAS __attribute__((address_space(4)))
typedef const float* CFP;
typedef CAS const CFP* KargTab;
struct Frame {
    LAS unsigned char* lds; volatile LAS unsigned* MISC; unsigned* ctl;
    int tid, lane, wave, vcu, G, gw, NGW, wid0, probe;
    KargTab in; float* out; unsigned char* ws;
};
__device__ __forceinline__ float wave_sum(float v) {
    v += shfl_xor_c<1>(v); v += shfl_xor_c<2>(v); v += shfl_xor_c<4>(v); v += shfl_xor_c<8>(v); v += shfl_xor_c<16>(v);
    const int x = __builtin_bit_cast(int, v);
    return __builtin_bit_cast(float, __builtin_amdgcn_readlane(x, 0)) + __builtin_bit_cast(float, __builtin_amdgcn_readlane(x, 32));
}
__device__ __forceinline__ int cond_of_row(int r) { return r < MCTX ? 0 : 1 + ((r - MCTX) >> 12); }
__device__ __forceinline__ int rope_pos(int e) { const int w = e & 31; return (e & 32) + 8 * ((w & 15) >> 2) + 4 * (w >> 4) + (w & 3); }
__device__ __forceinline__ int rope_orig(int p) { const int q = p & 31; return (p & 32) + 16 * ((q >> 2) & 1) + 4 * (q >> 3) + (q & 3); }
enum { MAP_ID = 0, MAP_W1, MAP_W3, MAP_UQ, MAP_DOWN };
__device__ __forceinline__ int map_row(int mode, int off, int n) {
    if (mode == MAP_W1) return 256 * (n >> 7) + (n & 127);
    if (mode == MAP_W3) return 256 * (n >> 7) + 128 + (n & 127);
    if (mode == MAP_UQ) { const int h = n / 192, d = n - h * 192; return d < 128 ? n : h * 192 + 128 + rope_pos(d - 128); }
    if (mode == MAP_DOWN) return n < 1024 ? n : 1024 + rope_pos(n - 1024);
    return off + n;
}
__device__ __forceinline__ void tr_matrix(Frame& F, const float* W, int K, int N, int ldn, bf16* WT, int ldw, int mode, int off) {
    LAS float* scr = (LAS float*)(F.lds + RING_OFF + F.wave * 16384);
    const int nblk = N / 32, nitems = (K / 64) * nblk, lane = F.lane;
    for (int item = F.gw; item < nitems; item += F.NGW) {
        const int kb = item / nblk, nb = item - kb * nblk, k0 = 64 * kb, n0 = 32 * nb;
#pragma unroll 8
        for (int i = 0; i < 32; ++i) { const int kk = 2 * i + (lane >> 5); scr[kk * 33 + (lane & 31)] = W[(size_t)(k0 + kk) * ldn + n0 + (lane & 31)]; }
        LDS_WAIT(); asm volatile("" ::: "memory");
        const int c = lane & 7;
#pragma unroll
        for (int j = 0; j < 4; ++j) { const int n = (lane >> 3) + 8 * j; const LAS float* s = scr + (8 * c) * 33 + n;
            v4u o; o.x = pk2(s[0 * 33], s[1 * 33]); o.y = pk2(s[2 * 33], s[3 * 33]); o.z = pk2(s[4 * 33], s[5 * 33]); o.w = pk2(s[6 * 33], s[7 * 33]);
            *(GAS v4u*)(WT + (size_t)map_row(mode, off, n0 + n) * ldw + k0 + 8 * c) = o; }
        LDS_WAIT(); asm volatile("" ::: "memory");
    }
}
__device__ __forceinline__ void tr_matrix8(Frame& F, const float* W, int K, int N, int ldn, unsigned char* WT, int ldw, int mode, float scale) {
    LAS float* scr = (LAS float*)(F.lds + RING_OFF + F.wave * 16384);
    const int nblk = N / 32, nitems = (K / 64) * nblk, lane = F.lane;
    for (int item = F.gw; item < nitems; item += F.NGW) {
        const int kb = item / nblk, nb = item - kb * nblk, k0 = 64 * kb, n0 = 32 * nb;
#pragma unroll 8
        for (int i = 0; i < 32; ++i) { const int kk = 2 * i + (lane >> 5); scr[kk * 33 + (lane & 31)] = W[(size_t)(k0 + kk) * ldn + n0 + (lane & 31)] * scale; }
        LDS_WAIT(); asm volatile("" ::: "memory");
        const int c = lane & 3;
#pragma unroll
        for (int j = 0; j < 2; ++j) { const int n = (lane >> 2) + 16 * j; const LAS float* s = scr + (16 * c) * 33 + n;
            v4u o; o.x = pg8::pk4_fp8(s[0 * 33], s[1 * 33], s[2 * 33], s[3 * 33]); o.y = pg8::pk4_fp8(s[4 * 33], s[5 * 33], s[6 * 33], s[7 * 33]);
            o.z = pg8::pk4_fp8(s[8 * 33], s[9 * 33], s[10 * 33], s[11 * 33]); o.w = pg8::pk4_fp8(s[12 * 33], s[13 * 33], s[14 * 33], s[15 * 33]);
            *(GAS v4u*)(WT + (size_t)map_row(mode, 0, n0 + n) * ldw + k0 + 16 * c) = o; }
        LDS_WAIT(); asm volatile("" ::: "memory");
    }
}
__device__ __forceinline__ void p0_prologue(Frame& F) {
    KargTab in = F.in; unsigned char* ws = F.ws;
    if ((int)blockIdx.x < 2 * NMODC / 256) {
        LAS float* sl = (LAS float*)(F.lds + RING_OFF);
        for (int i = F.tid; i < NCOND * DM; i += NWAVES * 64) { const int ci = i / DM, k = i - ci * DM; const float c = ci == 0 ? in[I_CCTX][k] : in[I_C][(ci - 1) * DM + k];
            sl[k * 12 + ci] = c / (1.0f + __expf(-c)); }
        __syncthreads();
        const int col0 = (int)blockIdx.x * 256, l = col0 / NMODC, jj0 = col0 - l * NMODC;
        const float* wp = in[I_WMOD] + ((size_t)l * DM + F.wave * 256) * NMODC + jj0 + F.lane * 4;
        f32x4 acc[NCOND];
#pragma unroll
        for (int ci = 0; ci < NCOND; ++ci) acc[ci] = (f32x4){0.f, 0.f, 0.f, 0.f};
#pragma unroll 4
        for (int k = 0; k < 256; ++k) { const f32x4 w = *(const GAS f32x4*)(wp + (size_t)k * NMODC); const LAS f32x4* sp = (const LAS f32x4*)(sl + (F.wave * 256 + k) * 12);
            const f32x4 s0 = sp[0], s1 = sp[1], s2 = sp[2];
            acc[0] += w * s0[0]; acc[1] += w * s0[1]; acc[2] += w * s0[2]; acc[3] += w * s0[3]; acc[4] += w * s1[0]; acc[5] += w * s1[1]; acc[6] += w * s1[2]; acc[7] += w * s1[3]; acc[8] += w * s2[0]; }
        __syncthreads();
        LAS f32x4* pr = (LAS f32x4*)(F.lds + RING_OFF);
#pragma unroll
        for (int ci = 0; ci < NCOND; ++ci) pr[(F.wave * NCOND + ci) * 64 + F.lane] = acc[ci];
        __syncthreads();
        for (int i = F.tid; i < NCOND * 64; i += NWAVES * 64) { const int ci = i >> 6, ln = i & 63; f32x4 s = pr[(0 * NCOND + ci) * 64 + ln];
#pragma unroll
            for (int w = 1; w < NWAVES; ++w) s += pr[(w * NCOND + ci) * 64 + ln];
            s += *(const f32x4*)(in[I_BMOD] + (size_t)l * NMODC + jj0 + ln * 4);
            *(f32x4*)((float*)(ws + WS_MOD) + (size_t)ci * pg8::MODROW + (size_t)l * NMODC + jj0 + ln * 4) = s; }
        __syncthreads();
    }
    { const int gt = (int)blockIdx.x * NWAVES * 64 + F.tid;
      if (gt < 1024) { const int pos = gt >> 4, f = gt & 15; const float inv = __builtin_amdgcn_exp2f(-(float)f * 0.8304820237218406f); float rev = (float)pos * inv * 0.15915494309189535f; rev -= floorf(rev);
          float* t = (float*)(ws + WS_ROPE) + gt * 2; t[0] = __builtin_amdgcn_cosf(rev); t[1] = __builtin_amdgcn_sinf(rev); } }
    for (int f = 0; f < 4; ++f) {
        tr_matrix8(F, in[I_W1] + (size_t)f * DM * DFF, DM, DFF, DFF, ws + WS_W13 + f * SZ_W13, DM, MAP_W1, pg8::W13_SCALE);
        tr_matrix8(F, in[I_W3] + (size_t)f * DM * DFF, DM, DFF, DFF, ws + WS_W13 + f * SZ_W13, DM, MAP_W3, pg8::W13_SCALE);
        tr_matrix8(F, in[I_W2] + (size_t)f * DFF * DM, DFF, DM, DM, ws + WS_W2 + f * SZ_W2, DFF, MAP_ID, pg8::W2_SCALE);
    }
    tr_matrix(F, in[I_WIN], DM, 4096, 4096, (bf16*)(ws + WS_WIN), DM, MAP_ID, 0);
    tr_matrix8(F, in[I_WIN], DM, 4096, 4096, ws + WS_WIN8, DM, MAP_ID, pg8::W13_SCALE);
    tr_matrix8(F, in[I_WMIXO], 1024, DM, DM, ws + WS_WMIX, DM, MAP_ID, pg8::W2_SCALE);
    tr_matrix(F, in[I_WDOWN], DM, 1088, 1088, (bf16*)(ws + WS_WDOWN), DM, MAP_DOWN, 0);
    tr_matrix8(F, in[I_WDOWN], DM, 1088, 1088, ws + WS_WDOWN8, DM, MAP_DOWN, pg8::W13_SCALE);
    tr_matrix8(F, in[I_WUQ], 512, 3072, 3072, ws + WS_WUQ, 512, MAP_UQ, 32.0f);
    tr_matrix8(F, in[I_WUKV], 512, 4096, 4096, ws + WS_WUKV, 512, MAP_ID, 32.0f);
    tr_matrix8(F, in[I_WOUT], DM, DM, DM, ws + WS_WOUT, DM, MAP_ID, pg8::W2_SCALE);
    { v4u* z = (v4u*)(ws + WS_WDOWN + (size_t)1088 * DM * 2); const int n16 = (NDOWN - 1088) * DM * 2 / 16;
      for (int i = (int)blockIdx.x * NWAVES * 64 + F.tid; i < n16; i += F.G * NWAVES * 64) z[i] = (v4u){0u, 0u, 0u, 0u};
      v4u* z8 = (v4u*)(ws + WS_WDOWN8 + (size_t)1088 * DM); const int m16 = (NDOWN - 1088) * DM / 16;
      for (int i = (int)blockIdx.x * NWAVES * 64 + F.tid; i < m16; i += F.G * NWAVES * 64) z8[i] = (v4u){0u, 0u, 0u, 0u}; }
    for (int item = (int)blockIdx.x; item < 512; item += F.G) {
        const int jb = item & 3, cb = (item >> 2) & 31, g = item >> 7, j = jb * 512 + F.tid, c0 = cb * 8;
        const float* wo = in[I_WMIXO] + (size_t)(1024 + g * 256) * DM + j; const float* ps = in[I_POOLS] + g * 256; const float* pw = in[I_POOLW] + ((size_t)g * 256 + c0) * 256;
        float a[8];
#pragma unroll
        for (int i = 0; i < 8; ++i) a[i] = 0.f;
#pragma unroll 4
        for (int d = 0; d < 256; ++d) { const float w = wo[(size_t)d * DM] * ps[d];
#pragma unroll
            for (int i = 0; i < 8; ++i) a[i] = fmaf(pw[i * 256 + d], w, a[i]); }
        v2u o; o.x = pg8::pk4_fp8(a[0] * pg8::W2_SCALE, a[1] * pg8::W2_SCALE, a[2] * pg8::W2_SCALE, a[3] * pg8::W2_SCALE); o.y = pg8::pk4_fp8(a[4] * pg8::W2_SCALE, a[5] * pg8::W2_SCALE, a[6] * pg8::W2_SCALE, a[7] * pg8::W2_SCALE);
        *(v2u*)(ws + WS_WMIX + (size_t)j * DM + 1024 + g * 256 + c0) = o;
    }
}
__device__ __forceinline__ void cast_na_cache(Frame& F) {
    KargTab in = F.in; unsigned char* ws = F.ws;
    const int n8 = MCACHE * 1024 / 8;
    for (int i = (int)blockIdx.x * NWAVES * 64 + F.tid; i < 2 * n8; i += F.G * NWAVES * 64) { const int which = i >= n8, e = (which ? i - n8 : i) * 8;
        const float* s = in[which ? I_CNV : I_CNK] + e; const f32x4 a = *(const f32x4*)s, b = *(const f32x4*)(s + 4);
        v4u o; o.x = pk2(a[0], a[1]); o.y = pk2(a[2], a[3]); o.z = pk2(b[0], b[1]); o.w = pk2(b[2], b[3]);
        *(v4u*)((bf16*)(ws + WS_EQ + (which ? 2 : 1) * SZ_QKVU) + (size_t)MTOK * 1024 + e) = o; }
}
__device__ __forceinline__ void p0b_modulate(Frame& F) {
    const float* modtab = (const float*)(F.ws + WS_MOD);
    { float* idln = (float*)(F.ws + WS_IDLN); const int gt = (int)blockIdx.x * NWAVES * 64 + F.tid; if (gt < 2 * DM) idln[gt] = gt < DM ? 1.0f : 0.0f; }
    { float* ab = (float*)(F.ws + WS_AB);
      for (int i = (int)blockIdx.x * NWAVES * 64 + F.tid; i < NCOND * 6 * DM; i += F.G * NWAVES * 64) { const int c = i % DM, q = (i / DM) % 6, ci = i / (6 * DM);
          const float g = F.in[I_LNG][q * DM + c], b = F.in[I_LNB][q * DM + c]; float A = g, B = b;
          if (q < 5) { const int qn = q + 1, ln = qn / 3, jn = qn % 3; const float* mt = modtab + (size_t)ci * pg8::MODROW + (size_t)(ln * 9 + 3 * jn) * DM; const float sh = mt[c], sc = mt[DM + c]; A = g * (1.0f + sc); B = b * (1.0f + sc) + sh; }
          ab[((size_t)(ci * 6 + q) * 2 + 0) * DM + c] = A; ab[((size_t)(ci * 6 + q) * 2 + 1) * DM + c] = B; } }
    for (int r = F.gw; r < MTOK; r += F.NGW) {
        const float* src = r < MCTX ? F.in[I_XP] + (size_t)r * DM : F.in[I_XS] + (size_t)(r - MCTX) * DM;
        const float* mt = modtab + (size_t)cond_of_row(r) * pg8::MODROW;
        unsigned char* ho = F.ws + WS_H + (size_t)r * DM;
        if (F.lane == 0) { typedef float f32x2_t __attribute__((ext_vector_type(2))); *(f32x2_t*)((float*)(F.ws + WS_ST) + 2 * (size_t)r) = (f32x2_t){1.0f, 0.0f}; }
#pragma unroll
        for (int j = 0; j < 8; ++j) { const int c = F.lane * 4 + 256 * j; const f32x4 v = *(const GAS f32x4*)(src + c), sh = *(const f32x4*)(mt + c), sc = *(const f32x4*)(mt + DM + c);
            const f32x4 h = v * (sc + 1.0f) + sh; *(GAS unsigned*)(ho + c) = pg8::pk4_fp8(h[0], h[1], h[2], h[3]);
            { typedef _Float16 h16x4 __attribute__((ext_vector_type(4))); *(GAS h16x4*)((bf16*)(F.ws + WS_T) + (size_t)r * DM + c) = __builtin_convertvector(v, h16x4); } }
    }
}
template <int OUT> __device__ __forceinline__ void ln_phase_t(Frame& F, int q, int r_begin, int r_end, int widx, int nw) {
    const float* ab = (const float*)(F.ws + WS_AB); float* ST = (float*)(F.ws + WS_ST); const bf16* T = (const bf16*)(F.ws + WS_T);
    v4u w[4], nxw[4];
#define LN_LOAD(dst, r) do { if ((r) < r_end) { const bf16* xr_ = T + (size_t)(r) * DM + F.lane * 8; _Pragma("unroll") for (int j = 0; j < 4; ++j) dst[j] = *(const GAS v4u*)(xr_ + 512 * j); } } while (0)
    int r = r_begin + widx; LN_LOAD(w, r);
    for (; r < r_end; r += nw) {
        const float* abr = ab + (size_t)(cond_of_row(r) * 6 + q) * 2 * DM + F.lane * 8;
        f32x4 A[8], B[8];
#pragma unroll
        for (int j = 0; j < 4; ++j) { A[2 * j] = *(const GAS f32x4*)(abr + 512 * j); A[2 * j + 1] = *(const GAS f32x4*)(abr + 512 * j + 4); B[2 * j] = *(const GAS f32x4*)(abr + DM + 512 * j); B[2 * j + 1] = *(const GAS f32x4*)(abr + DM + 512 * j + 4); }
        LN_LOAD(nxw, r + nw);
        f32x4 v[8]; float s = 0.f;
#pragma unroll
        for (int j = 0; j < 4; ++j) { const pg8::f32x8_t wf = __builtin_convertvector(__builtin_bit_cast(pg8::h16x8, w[j]), pg8::f32x8_t);
            v[2 * j] = (f32x4){wf[0], wf[1], wf[2], wf[3]}; v[2 * j + 1] = (f32x4){wf[4], wf[5], wf[6], wf[7]}; }
#pragma unroll
        for (int j = 0; j < 8; ++j) s += (v[j][0] + v[j][1]) + (v[j][2] + v[j][3]);
        const float mean = wave_sum(s) * (1.f / DM); float s2 = 0.f;
#pragma unroll
        for (int j = 0; j < 8; ++j) { v[j] = v[j] - mean; s2 += (v[j][0] * v[j][0] + v[j][1] * v[j][1]) + (v[j][2] * v[j][2] + v[j][3] * v[j][3]); }
        const float rstd = 1.f / sqrtf(wave_sum(s2) * (1.f / DM) + LN_EPS);
        if (OUT != 2 && F.lane == 0) { typedef float f32x2_t __attribute__((ext_vector_type(2))); *(f32x2_t*)(ST + 2 * (size_t)r) = (f32x2_t){rstd, -mean * rstd}; }
#pragma unroll
        for (int j = 0; j < 4; ++j) { const int c = F.lane * 8 + 512 * j; const f32x4 h0 = v[2 * j] * rstd * A[2 * j] + B[2 * j], h1 = v[2 * j + 1] * rstd * A[2 * j + 1] + B[2 * j + 1];
            if (OUT == 2) { *(GAS f32x4*)(F.out + (size_t)r * DM + c) = h0; *(GAS f32x4*)(F.out + (size_t)r * DM + c + 4) = h1; }
            else if (OUT == 0 || OUT == 3) { v2u o; o.x = pg8::pk4_fp8(h0[0], h0[1], h0[2], h0[3]); o.y = pg8::pk4_fp8(h1[0], h1[1], h1[2], h1[3]); *(GAS v2u*)(F.ws + WS_H + (size_t)r * DM + c) = o;
                if (OUT == 3 && r < MCTX) { v4u ob; ob.x = pk2(h0[0], h0[1]); ob.y = pk2(h0[2], h0[3]); ob.z = pk2(h1[0], h1[1]); ob.w = pk2(h1[2], h1[3]); *(GAS v4u*)((bf16*)(F.ws + WS_H + (size_t)MTOK * DM) + (size_t)r * DM + c) = ob; } }
            else { v4u o; o.x = pk2(h0[0], h0[1]); o.y = pk2(h0[2], h0[3]); o.z = pk2(h1[0], h1[1]); o.w = pk2(h1[2], h1[3]); *(GAS v4u*)((bf16*)(F.ws + WS_H) + (size_t)r * DM + c) = o; } }
#pragma unroll
        for (int j = 0; j < 4; ++j) w[j] = nxw[j];
    }
#undef LN_LOAD
}
template <int HW> __device__ __forceinline__ void pool_rows(const bf16* U, unsigned char* CAT, int r0, int s0, int L, int col) {
    float v0[32 + 2 * HW], v1[32 + 2 * HW];
#pragma unroll
    for (int i = 0; i < 32 + 2 * HW; ++i) { const int r = r0 - HW + i; unsigned w = 0u; if (r >= s0 && r < s0 + L) w = *(const unsigned*)(U + (size_t)r * 1024 + col);
        v0[i] = bf2f((unsigned short)(w & 0xffffu)); v1[i] = bf2f((unsigned short)(w >> 16)); }
    float a0 = 0.f, a1 = 0.f;
#pragma unroll
    for (int i = 0; i < 2 * HW; ++i) { a0 += v0[i]; a1 += v1[i]; }
#pragma unroll
    for (int i = 0; i < 32; ++i) { const int t = r0 + i - s0; int lo = t - HW, hi = t + HW; lo = lo < 0 ? 0 : lo; hi = hi > L ? L : hi; const float inv = 1.0f / (float)(hi - lo);
        *(unsigned short*)(CAT + (size_t)(r0 + i) * DM + 1024 + col) = (unsigned short)__builtin_amdgcn_cvt_pk_fp8_f32((a0 * inv - v0[i + HW]) * att::O_SCALE, (a1 * inv - v1[i + HW]) * att::O_SCALE, 0, false);
        if (i < 31) { a0 += v0[i + 2 * HW] - v0[i]; a1 += v1[i + 2 * HW] - v1[i]; } }
}
__device__ __forceinline__ void pool_item(Frame& F, int item) {
    const bf16* U = (const bf16*)(F.ws + WS_EQ + 3 * SZ_QKVU); unsigned char* CAT = F.ws + WS_CAT;
    const int r0 = item * 32, s0 = r0 < MCTX ? (r0 & ~255) : MCTX + ((r0 - MCTX) & ~4095), L = r0 < MCTX ? 256 : 4096;
    const int col = F.tid * 2, g = F.wave >> 1;
    if (g == 0) pool_rows<1>(U, CAT, r0, s0, L, col); else if (g == 1) pool_rows<2>(U, CAT, r0, s0, L, col); else if (g == 2) pool_rows<4>(U, CAT, r0, s0, L, col); else pool_rows<8>(U, CAT, r0, s0, L, col);
}
__device__ __forceinline__ void rms_phase(Frame& F) {
    const _Float16* DOWN = (const _Float16*)(F.ws + WS_DOWN); bf16* CQ = (bf16*)(F.ws + WS_CQ); bf16* CKV = (bf16*)(F.ws + WS_CKV); bf16* KPE = (bf16*)(F.ws + WS_KPE);
    const float* tab = (const float*)(F.ws + WS_ROPE);
    f32x4 qn[2], kn[2];
#pragma unroll
    for (int j = 0; j < 2; ++j) { qn[j] = *(const GAS f32x4*)(F.in[I_QNORM] + F.lane * 4 + 256 * j); kn[j] = *(const GAS f32x4*)(F.in[I_KVNORM] + F.lane * 4 + 256 * j); }
    const int p = F.lane, fidx = 4 * ((p & 31) >> 3) + (p & 3), porig = rope_orig(p);
    typedef _Float16 h4_ __attribute__((ext_vector_type(4)));
    h4_ ha[2], hb[2], nha[2], nhb[2]; _Float16 hk = (_Float16)0.f, nhk = (_Float16)0.f;
#define RMS_LOAD(A_, B_, K_, r) do { if ((r) < MTOK) { const _Float16* d_ = DOWN + (size_t)(r) * NDOWN; _Pragma("unroll") for (int j = 0; j < 2; ++j) { A_[j] = *(const GAS h4_*)(d_ + F.lane * 4 + 256 * j); B_[j] = *(const GAS h4_*)(d_ + 512 + F.lane * 4 + 256 * j); } K_ = d_[1024 + p]; } } while (0)
    int r = F.gw; RMS_LOAD(ha, hb, hk, r);
    for (; r < MTOK; r += F.NGW) {
        float cs = 1.f, sn = 0.f;
        if (r >= MCTX) { const int t = (r - MCTX) & 4095, pos = (p & 32) ? (t & 63) : (t >> 6); const float* tp = tab + (pos * 16 + fidx) * 2; cs = tp[0]; sn = tp[1]; }
        RMS_LOAD(nha, nhb, nhk, r + F.NGW);
        f32x4 a[2], b[2];
#pragma unroll
        for (int j = 0; j < 2; ++j) { a[j] = (f32x4){(float)ha[j][0], (float)ha[j][1], (float)ha[j][2], (float)ha[j][3]}; b[j] = (f32x4){(float)hb[j][0], (float)hb[j][1], (float)hb[j][2], (float)hb[j][3]}; }
        const float kv = (float)hk;
        float sa = 0.f, sb = 0.f;
#pragma unroll
        for (int j = 0; j < 2; ++j) { sa += (a[j][0] * a[j][0] + a[j][1] * a[j][1]) + (a[j][2] * a[j][2] + a[j][3] * a[j][3]); sb += (b[j][0] * b[j][0] + b[j][1] * b[j][1]) + (b[j][2] * b[j][2] + b[j][3] * b[j][3]); }
        const float ra = 1.f / sqrtf(wave_sum(sa) * (1.f / 512) + RMS_EPS), rb = 1.f / sqrtf(wave_sum(sb) * (1.f / 512) + RMS_EPS);
#pragma unroll
        for (int j = 0; j < 2; ++j) { const int c = F.lane * 4 + 256 * j; const f32x4 ya = a[j] * ra * qn[j], yb = b[j] * rb * kn[j];
            *(GAS unsigned*)((unsigned char*)CQ + (size_t)r * 512 + c) = pg8::pk4_fp8(ya[0], ya[1], ya[2], ya[3]);
            *(GAS unsigned*)((unsigned char*)CKV + (size_t)r * 512 + c) = pg8::pk4_fp8(yb[0], yb[1], yb[2], yb[3]);
            if (r < MCTX) *(GAS f32x4*)(F.out + OUT_CKV + (size_t)r * 512 + c) = yb; }
        const float pv = shfl_xor_c<4>(kv);
        const float o = (p & 4) ? (kv * cs + pv * sn) : (kv * cs - pv * sn);
        if (r < MCTX) F.out[OUT_KPE + (size_t)r * 64 + porig] = kv;
        ((unsigned char*)KPE)[(size_t)r * 64 + p] = (unsigned char)(__builtin_amdgcn_cvt_pk_fp8_f32(o, o, 0, false) & 0xff);
#pragma unroll
        for (int j = 0; j < 2; ++j) { ha[j] = nha[j]; hb[j] = nhb[j]; }
        hk = nhk;
    }
#undef RMS_LOAD
    for (int i = F.gw; i < MCACHE; i += F.NGW) { const int rr = MTOK + i; const float* ck = F.in[I_CCKV] + (size_t)i * 512;
        const f32x4 y0 = *(const GAS f32x4*)(ck + F.lane * 4), y1 = *(const GAS f32x4*)(ck + F.lane * 4 + 256); const float kp = F.in[I_CKPE][(size_t)i * 64 + porig];
        *(GAS unsigned*)((unsigned char*)CKV + (size_t)rr * 512 + F.lane * 4) = pg8::pk4_fp8(y0[0], y0[1], y0[2], y0[3]);
        *(GAS unsigned*)((unsigned char*)CKV + (size_t)rr * 512 + F.lane * 4 + 256) = pg8::pk4_fp8(y1[0], y1[1], y1[2], y1[3]);
        ((unsigned char*)KPE)[(size_t)rr * 64 + p] = (unsigned char)(__builtin_amdgcn_cvt_pk_fp8_f32(kp, kp, 0, false) & 0xff); }
}
__device__ __forceinline__ void even_attn_phase(Frame& F, LAS unsigned char* lds_att) {
    const bf16* Q = (const bf16*)(F.ws + WS_EQ); const bf16* K = (const bf16*)(F.ws + WS_EQ + SZ_QKVU); const bf16* V = (const bf16*)(F.ws + WS_EQ + 2 * SZ_QKVU); unsigned char* CAT = F.ws + WS_CAT;
    for (int u = F.vcu; u < 1152; u += F.G) {
        att::UnitArgs A; A.KR = nullptr; A.C = 0.08838834764831845f * 1.4426950408889634f; A.seg0_tiles = 4;
        int row0, h;
        if (u < 1024) { const int qb = u & 15, b = u >> 7; h = (u >> 4) & 7; row0 = MCTX + b * 4096 + qb * 256;
            const int r0 = 4 * qb; const int lo = qb == 0 ? 0 : (qb == 15 ? 56 : (r0 - 4 < 52 ? r0 - 4 : 52)); const int nloc = (qb == 0 || qb == 15) ? 8 : 12;
            A.NT = 4 + nloc; A.seg0_row = MTOK + b * 256; A.seg1_row = MCTX + b * 4096 + lo * 64; A.rpb = F.in[I_RPB] + h * 465; A.lo_row = lo; A.r0 = r0; }
        else { const int v = u - 1024, b = v >> 3; h = v & 7; row0 = b * 256; A.NT = 4; A.seg0_row = row0; A.seg1_row = 0; A.rpb = nullptr; A.lo_row = 0; A.r0 = 0; }
        A.Q = Q + (size_t)row0 * 1024 + h * 128; A.K = K + h * 128; A.V = V + h * 128; A.O = CAT + (size_t)row0 * DM + h * 128;
        att::attn_unit<1>(A, lds_att, F.wid0);
    }
    for (int u = F.vcu; u < 1152; u += F.G) pool_item(F, u);
    { const int n8 = MCTX * 1024 / 8;
      for (int i = (int)blockIdx.x * NWAVES * 64 + F.tid; i < 2 * n8; i += F.G * NWAVES * 64) { const int which = i >= n8, e = (which ? i - n8 : i) * 8;
          const v4u w = *(const v4u*)((which ? V : K) + e); float* o = F.out + (which ? OUT_NAV : OUT_NAK) + e;
          *(f32x4*)o = (f32x4){bf2f((unsigned short)(w.x & 0xffffu)), bf2f((unsigned short)(w.x >> 16)), bf2f((unsigned short)(w.y & 0xffffu)), bf2f((unsigned short)(w.y >> 16))};
          *(f32x4*)(o + 4) = (f32x4){bf2f((unsigned short)(w.z & 0xffffu)), bf2f((unsigned short)(w.z >> 16)), bf2f((unsigned short)(w.w & 0xffffu)), bf2f((unsigned short)(w.w >> 16))}; } }
}
template <int VAR = 0> __device__ __forceinline__ void odd_attn_phase(Frame& F, LAS unsigned char* lds_att) {
    const unsigned char* Q8 = F.ws + WS_MQ; const unsigned char* K8 = F.ws + WS_KV; const unsigned char* VT8 = F.ws + WS_KV + (size_t)MKV * 2048; const unsigned char* KPE8 = F.ws + WS_KPE; unsigned char* O = F.ws + WS_H;
    for (int u = F.vcu; u < 2304; u += F.G) {
        att::UnitArgs A; A.KR = (const bf16*)KPE8; A.C = 0.07216878364870322f * 1.4426950408889634f; A.rpb = nullptr; A.lo_row = 0; A.r0 = 0;
        int row0, h;
        if (u < 2048) { const int qb = u & 15; h = (u >> 4) & 15; const int b = u >> 8; row0 = MCTX + b * 4096 + qb * 256;
            A.NT = 68; A.seg0_tiles = 64; A.seg0_row = MCTX + b * 4096; A.seg1_row = MTOK + b * 256; }
        else { const int v = u - 2048; h = v & 15; const int b = v >> 4; row0 = b * 256; A.NT = 4; A.seg0_tiles = 4; A.seg0_row = row0; A.seg1_row = 0; }
        A.Q = (const bf16*)(Q8 + (size_t)row0 * 3072 + h * 192); A.K = (const bf16*)(K8 + h * 128); A.V = (const bf16*)(VT8 + (size_t)h * 128 * MKV); A.O = O + (size_t)row0 * DM + h * 128;
        att::attn_unit<2, VAR>(A, lds_att, F.wid0);
    }
}

#define RESID_SEQ(MASKID, GEMM_INIT, EPI_INIT, RB_ROWS, LN_DISPATCH, EXTRA_C) \
    for (int part = 0; part < 3; ++part) { PH_BEGIN(MASKID) \
        const int n_units = (MTOK / 256) * 8, full = (n_units / F.G) * F.G, left = n_units - full; \
        if (part < 2) { pg8::Gemm g GEMM_INIT; pg8::PanelOrder S{part ? full : 0, part ? n_units : full, 8, F.G, F.vcu}; pg8::EpiResid E EPI_INIT; \
            pg8::gemm_phase<pg8::EpiResid, pg8::PanelOrder, true, true, true>(ring, g, S, E, wid0); \
            F.lane = hw_lane(); F.tid = F.wave * 64 + F.lane; }     \
        if (part == 2 || (part == 1 && F.vcu >= left)) { const int rb_ = (RB_ROWS); \
            const int r0_ = part == 1 ? 0 : rb_, r1_ = part == 1 ? rb_ : MTOK, wi_ = part == 1 ? (F.vcu - left) * NWAVES + F.wave : F.gw, nw_ = part == 1 ? (F.G - left) * NWAVES : F.NGW; \
            LN_DISPATCH(r0_, r1_, wi_, nw_) } \
        if (part == 2) { EXTRA_C } \
    PH_END }

__device__ __forceinline__ unsigned long long launder_u64(unsigned long long p) { asm volatile("" : "+s"(p)); return p; }
__device__ __forceinline__ void frame_init(Frame& F, LAS unsigned char* lds, const int wid0) {
    int wid_ = wid0; asm volatile("" : "+s"(wid_));
    const int lane = hw_lane(), tid = wid_ * 64 + lane;
    F.lds = lds; F.MISC = (volatile LAS unsigned*)(lds + MISC_OFF);
    F.tid = tid; F.lane = lane; F.wave = wid_; F.wid0 = wid0;
    F.G = gridDim.x; { const int bx = blockIdx.x; F.vcu = (F.G % 8 == 0) ? (bx % 8) * (F.G / 8) + bx / 8 : bx; }
    F.gw = F.vcu * NWAVES + F.wave; F.NGW = F.G * NWAVES;
    CAS const unsigned char* kp = (CAS const unsigned char*)launder_u64((unsigned long long)__builtin_amdgcn_kernarg_segment_ptr());
    F.in = (KargTab)kp; { typedef float* FP_; typedef unsigned char* UP_; F.out = *(CAS const FP_*)(kp + N_IN * 8); F.ws = *(CAS const UP_*)(kp + N_IN * 8 + 8); } F.ctl = (unsigned*)(F.ws + WS_CTL); F.probe = *(CAS const int*)(kp + N_IN * 8 + 28);
}
static_assert(sizeof(Args) == N_IN * 8 + 32, "Args layout");
static_assert(att::VT_PITCH == MKV, "transposed-V row pitch");
__global__ void __launch_bounds__(NWAVES * 64, 2) fwd_kernel(Args args) {
    extern __shared__ __attribute__((aligned(16))) unsigned char lds_raw[];
    LAS unsigned char* const ldsb = (LAS unsigned char*)lds_raw;
    const int wid0 = __builtin_amdgcn_readfirstlane((int)threadIdx.x >> 6);
    for (int u = threadIdx.x; u < (LDS_BYTES - LDSCTL_OFF) / 4; u += NWAVES * 64) ((LAS unsigned*)(ldsb + LDSCTL_OFF))[u] = 0u;
    __syncthreads();
    XcdBarrier bar = xcd_barrier_post((unsigned*)(args.ws + WS_CTL) + CW_BAR + args.li * XCD_BAR_WORDS, (volatile LAS unsigned*)(ldsb + MISC_OFF) + 8, wid0);
    const int lo = args.ph_lo, hi = args.ph_hi; int ph = 0;
#ifndef PHASE_MASK
#define PHASE_MASK 0xFFFF
#endif
#define PHON(k) (((PHASE_MASK) >> (k)) & 1)
#define PH_BEGIN(k) if (PHON(k) && lo <= ph && ph < hi) { asm volatile("; PHASE_MARK " #k ::: "memory"); Frame F; frame_init(F, ldsb, wid0); \
    unsigned char* const ws = F.ws; LAS unsigned char* const ring = F.lds + RING_OFF; const float* const modtab = (const float*)(ws + WS_MOD); (void)ring; (void)modtab;
#define PH_END   if (ph + 1 < hi) { xcd_barrier(bar); if ((F.probe >> 9) & 1) xcd_barrier(bar); } } ++ph;

    PH_BEGIN(0) for (int rep = 0; rep < 1 + ((F.probe >> 2) & 1); ++rep) p0_prologue(F); PH_END
    PH_BEGIN(1) for (int rep = 0; rep < 1 + ((F.probe >> 7) & 1); ++rep) p0b_modulate(F); PH_END
#pragma unroll 1
    for (int f = 0; f < 4; ++f) {
        const int l = f >> 1, slot = f & 1, jsub = slot ? 2 : 0;
        PH_BEGIN(2)
            pg8::Gemm g{(const pg8::bf16_t*)(ws + WS_H), (const pg8::bf16_t*)(ws + WS_W13 + f * SZ_W13), MTOK, 2 * DFF, DM / 2}; pg8::StaticOrder S; S.init(MTOK, 2 * DFF, F.G, (int)blockIdx.x);
            pg8::EpiSwiGLU E{ws + WS_G, DFF};
            for (int rep = 0; rep < 1 + (F.probe & 1); ++rep)
            pg8::gemm_phase<pg8::EpiSwiGLU, pg8::StaticOrder, true, true, true>(ring, g, S, E, wid0);
        PH_END
        {
            const int qp = l * 3 + jsub - 1, q = l * 3 + jsub; const bool first = qp < 0;
            const unsigned long long fm = 0ull - (unsigned long long)first;
#define BLEND_PTR(a, b) ((const float*)(((unsigned long long)(a) & fm) | ((unsigned long long)(b) & ~fm)))
#define LN_FFN(r0, r1, wi, nw) { if (slot == 0) { ln_phase_t<3>(F, q, r0, r1, wi, nw); } else if (q < 5) ln_phase_t<0>(F, q, r0, r1, wi, nw); else ln_phase_t<2>(F, q, r0, r1, wi, nw); }
            RESID_SEQ(3, ({(const pg8::bf16_t*)(ws + WS_G), (const pg8::bf16_t*)(ws + WS_W2 + f * SZ_W2), MTOK, DM, DFF / 2}),
                      ({(pg8::bf16_t*)(ws + WS_T), modtab + (size_t)(l * 9 + 3 * jsub + 2) * DM, (const float*)(ws + WS_ST), BLEND_PTR(ws + WS_IDLN, F.in[I_LNG] + (size_t)(first ? 0 : qp) * DM), BLEND_PTR((const float*)(ws + WS_IDLN) + DM, F.in[I_LNB] + (size_t)(first ? 0 : qp) * DM), 0.5 / pg8::W2_SCALE}),
                      112 * 256, LN_FFN, if (f == 0) cast_na_cache(F);)
#undef LN_FFN
#undef BLEND_PTR
        }
        if (f == 0) {
            PH_BEGIN(5)
                { pg8::Gemm g{(const pg8::bf16_t*)(ws + WS_H), (const pg8::bf16_t*)(ws + WS_WIN8), MTOK, 4096, DM / 2}; pg8::StaticOrder S; S.init(MTOK, 4096, F.G, (int)blockIdx.x);
                  pg8::EpiBf16 E{(pg8::bf16_t*)(ws + WS_EQ), 1024, 1024, SZ_QKVU / 2, 1.0 / pg8::W13_SCALE, 16};
                  for (int rep = 0; rep < 1 + ((F.probe >> 4) & 1); ++rep)
                  pg8::gemm_phase<pg8::EpiBf16, pg8::StaticOrder, true, true, true>(ring, g, S, E, wid0); }
                __syncthreads();
                { pg8::Gemm g{(const pg8::bf16_t*)(ws + WS_H + (size_t)MTOK * DM), (const pg8::bf16_t*)(ws + WS_WIN + (size_t)1024 * DM * 2), MCTX, 2048, DM}; pg8::StaticOrder S; S.init(MCTX, 2048, F.G, (int)blockIdx.x);
                  pg8::EpiBf16 E{(pg8::bf16_t*)(ws + WS_EQ + SZ_QKVU), 1024, 1024, SZ_QKVU / 2, 1.0, 0};
                  pg8::gemm_phase<pg8::EpiBf16, pg8::StaticOrder, true, true>(ring, g, S, E, wid0); }
            PH_END
            PH_BEGIN(6) for (int rep = 0; rep < 1 + ((F.probe >> 3) & 1); ++rep) even_attn_phase(F, ring); PH_END
#define LN_MIX0(r0, r1, wi, nw) { ln_phase_t<0>(F, 0 * 3 + 1, r0, r1, wi, nw); }
            RESID_SEQ(7, ({(const pg8::bf16_t*)(ws + WS_CAT), (const pg8::bf16_t*)(ws + WS_WMIX), MTOK, DM, DM / 2}),
                      ({(pg8::bf16_t*)(ws + WS_T), modtab + (size_t)(0 * 9 + 3 * 1 + 2) * DM, (const float*)(ws + WS_ST), F.in[I_LNG] + (size_t)0 * DM, F.in[I_LNB] + (size_t)0 * DM, 1.0 / (pg8::W2_SCALE * att::O_SCALE)}),
                      40 * 256, LN_MIX0, )
#undef LN_MIX0
        }
        if (f == 2) {
            PH_BEGIN(8)
                { pg8::Gemm g{(const pg8::bf16_t*)(ws + WS_H + (size_t)MTOK * DM), (const pg8::bf16_t*)(ws + WS_WDOWN + (size_t)512 * DM * 2), MCTX, 768, DM}; pg8::PanelOrder S{0, 48, 3, F.G, F.vcu};
                  pg8::EpiF16 E{(pg8::bf16_t*)(ws + WS_DOWN) + 512, NDOWN, 1.0};
                  pg8::gemm_phase<pg8::EpiF16, pg8::PanelOrder, true, true>(ring, g, S, E, wid0); }
                __syncthreads();
                { pg8::Gemm g{(const pg8::bf16_t*)(ws + WS_H), (const pg8::bf16_t*)(ws + WS_WDOWN8), MTOK, NDOWN, DM / 2}; pg8::DownOrder S{F.G, F.vcu};
                  pg8::EpiF16 E{(pg8::bf16_t*)(ws + WS_DOWN), NDOWN, 1.0 / pg8::W13_SCALE};
                  for (int rep = 0; rep < 1 + ((F.probe >> 5) & 1); ++rep)
                  pg8::gemm_phase<pg8::EpiF16, pg8::DownOrder, true, true, true>(ring, g, S, E, wid0); }
            PH_END
            PH_BEGIN(9) for (int rep = 0; rep < 1 + ((F.probe >> 7) & 1); ++rep) rms_phase(F); PH_END
            PH_BEGIN(10)
#if !defined(G67_ONLY) || G67_ONLY == 1
                { pg8::Gemm g{(const pg8::bf16_t*)(ws + WS_CKV), (const pg8::bf16_t*)(ws + WS_WUKV), MKV, 4096, 256}; pg8::StaticOrder S; S.init(MKV, 4096, F.G, (int)blockIdx.x);
                  pg8::EpiKV8 E{ws + WS_KV, ws + WS_KV + (size_t)MKV * 2048, 1.0 / 32.0};
                  for (int rep = 0; rep < 1 + (((F.probe >> 5) | (F.probe >> 10)) & 1); ++rep)
                  pg8::gemm_phase<pg8::EpiKV8, pg8::StaticOrder, true, true, true>(ring, g, S, E, wid0); }
#endif
                __syncthreads();
#if !defined(G67_ONLY) || G67_ONLY == 2
                { pg8::Gemm g{(const pg8::bf16_t*)(ws + WS_CQ), (const pg8::bf16_t*)(ws + WS_WUQ), MTOK, 3072, 256}; pg8::StaticOrder S; S.init(MTOK, 3072, F.G, (int)blockIdx.x);
                  { LAS float* tl = (LAS float*)(F.lds + MISC_OFF + 1024); const float* tg = (const float*)(ws + WS_ROPE);
                    for (int i = F.wave * 64 + hw_lane(); i < 2048; i += NWAVES * 64) tl[i] = tg[i]; }
                  __syncthreads();
                  pg8::EpiQRope E{ws + WS_MQ, (long)(unsigned)(uintptr_t)(F.lds + MISC_OFF + 1024)};
                  for (int rep = 0; rep < 1 + (((F.probe >> 5) | (F.probe >> 11)) & 1); ++rep)
                  pg8::gemm_phase<pg8::EpiQRope, pg8::StaticOrder, true, true, true>(ring, g, S, E, wid0); }
#endif
            PH_END
#ifdef MK_VAR
            PH_BEGIN(11) odd_attn_phase<MK_VAR>(F, ring); for (int rep = 0; rep < 1 + ((F.probe >> 1) & 1); ++rep) odd_attn_phase(F, ring); PH_END
#else
            PH_BEGIN(11) for (int rep = 0; rep < 1 + ((F.probe >> 1) & 1); ++rep) odd_attn_phase(F, ring); PH_END
#endif
#define LN_MIX1(r0, r1, wi, nw) { ln_phase_t<0>(F, 1 * 3 + 1, r0, r1, wi, nw); }
            RESID_SEQ(12, ({(const pg8::bf16_t*)(ws + WS_H), (const pg8::bf16_t*)(ws + WS_WOUT), MTOK, DM, DM / 2}),
                      ({(pg8::bf16_t*)(ws + WS_T), modtab + (size_t)(1 * 9 + 3 * 1 + 2) * DM, (const float*)(ws + WS_ST), F.in[I_LNG] + (size_t)3 * DM, F.in[I_LNB] + (size_t)3 * DM, 1.0 / (pg8::W2_SCALE * att::O_SCALE)}),
                      40 * 256, LN_MIX1, )
#undef LN_MIX1
        }
    }
#undef PH_BEGIN
#undef PH_END
}
constexpr int N_PHASES = 2 + 4 * 4 + 5 + 7;

#ifndef MK_PER_PHASE
#define MK_PER_PHASE 0
#endif
extern "C" void kernel_launch(void* const* d_in, const int* in_sizes, int n_in, void* d_out, int out_size, void* d_ws, size_t ws_size, hipStream_t stream) {
    static int grid = 0;
    if (grid == 0) {
        if (n_in != N_IN || out_size != (int)OUT_END) fprintf(stderr, "kernel_launch: warning: n_in %d (expect %d) out %d (expect %zu)\n", n_in, (int)N_IN, out_size, (size_t)OUT_END);
        if (ws_size < WS_END) { fprintf(stderr, "kernel_launch: workspace too small: %zu < %zu\n", ws_size, (size_t)WS_END); grid = -1; return; }
        int dev = 0, cus = 0, per_cu = 0;
        if (hipGetDevice(&dev) != hipSuccess || hipDeviceGetAttribute(&cus, hipDeviceAttributeMultiprocessorCount, dev) != hipSuccess) { grid = -1; return; }
        if (hipFuncSetAttribute((const void*)fwd_kernel, hipFuncAttributeMaxDynamicSharedMemorySize, LDS_BYTES) != hipSuccess) { fprintf(stderr, "kernel_launch: hipFuncSetAttribute failed\n"); grid = -1; return; }
        if (hipOccupancyMaxActiveBlocksPerMultiprocessor(&per_cu, (const void*)fwd_kernel, NWAVES * 64, LDS_BYTES) != hipSuccess || per_cu < 1) fprintf(stderr, "kernel_launch: occupancy query reports %d\n", per_cu);
        (void)hipGetLastError();
        grid = cus;
    }
    if (grid < 0) return;
    if (hipMemsetAsync((char*)d_ws + WS_CTL, 0, CTL_ZERO_BYTES, stream) != hipSuccess) return;
    Args a{};
    for (int i = 0; i < N_IN; ++i) a.in[i] = (const float*)d_in[i];
    a.out = (float*)d_out; a.ws = (unsigned char*)d_ws;
#ifndef MK_PROBE
#define MK_PROBE 0
#endif
    a.pad = MK_PROBE;
#if MK_PER_PHASE
    for (int p = 0; p < N_PHASES; ++p) { a.ph_lo = p; a.ph_hi = p + 1; a.li = p;
        hipLaunchKernelGGL(fwd_kernel, dim3(grid), dim3(NWAVES * 64), LDS_BYTES, stream, a); }
#else
    a.ph_lo = 0; a.ph_hi = N_PHASES; a.li = 0;
    hipLaunchKernelGGL(fwd_kernel, dim3(grid), dim3(NWAVES * 64), LDS_BYTES, stream, a);
#endif
    const hipError_t le = hipPeekAtLastError();
    if (le != hipSuccess) fprintf(stderr, "kernel_launch: launch failed: %s\n", hipGetErrorName(le));
}
```

```cpp
#include <hip/hip_runtime.h>
#include <cstdio>
#include <cstdint>
__device__ __forceinline__ int hw_lane() { unsigned z = 0u; asm volatile("" : "+v"(z)); return (int)__builtin_amdgcn_mbcnt_hi(~0u, __builtin_amdgcn_mbcnt_lo(~0u, z)); }
template <int M> __device__ __forceinline__ float shfl_xor_c(float v) {
  static_assert(M == 1 || M == 2 || M == 4 || M == 8 || M == 16, "mask");
  if constexpr (M == 1) return __builtin_bit_cast(float, __builtin_amdgcn_mov_dpp(__builtin_bit_cast(int, v), 0xB1, 0xF, 0xF, true));
  else if constexpr (M == 2) return __builtin_bit_cast(float, __builtin_amdgcn_mov_dpp(__builtin_bit_cast(int, v), 0x4E, 0xF, 0xF, true));
  else return __builtin_bit_cast(float, __builtin_amdgcn_ds_swizzle(__builtin_bit_cast(int, v), 0x1f | (M << 10)));
}
namespace pg8 {
#define PG8_LAS __attribute__((address_space(3)))
typedef unsigned short bf16_t;
typedef short bf16x8 __attribute__((ext_vector_type(8)));
typedef float f32x4 __attribute__((ext_vector_type(4)));
typedef unsigned u32x4 __attribute__((ext_vector_type(4)));
typedef int v4i_t __attribute__((ext_vector_type(4)));
typedef int v8i_t __attribute__((ext_vector_type(8)));
constexpr int BM = 256, BK = 64, HALF = 128, HTB = HALF * BK * 2  , STAGE_BYTES = 8 * HTB, NXCD = 8, WGM = 8;

__host__ __device__ __forceinline__ int lds_byte(int r, int c) { const int st = (r >> 4) * 2 + (c >> 5), rr = r & 15, cc = c & 31, ob = rr * 64 + cc * 2; return st * 1024 + (ob ^ (((ob >> 9) & 1) << 5)); }
__host__ __device__ __forceinline__ void stage_rc(int b, int& R, int& C) { const int st = b / 1024, sb = b % 1024, swz = sb ^ (((sb >> 9) & 1) << 5); R = (st >> 1) * 16 + swz / 64; C = (st & 1) * 32 + (swz % 64) / 2; }
__host__ __device__ __forceinline__ int perm32(int rho) { const int n = rho >> 4, i = rho & 15; return 8 * (i >> 2) + 4 * n + (i & 3); }

struct Unit { int pm, pn; };
struct Gemm { const bf16_t* A; const bf16_t* Bt; int M, N, K; };

struct StaticOrder {
    int nM, nN, nwg, G, c;
    __host__ __device__ void init(int M, int N, int G_, int c_) { nM = M / BM; nN = N / BM; nwg = nM * nN; G = G_; c = c_; }
    __host__ __device__ bool next(int i, Unit& u) const {
        const long L = (long)i * G + c; if (L >= nwg) return false;
        int wgid = (int)L; { const int q = nwg / NXCD, r = nwg % NXCD, xcd = wgid % NXCD, off = wgid / NXCD; wgid = (xcd < r ? xcd * (q + 1) : r * (q + 1) + (xcd - r) * q) + off; }
        const int nig = WGM * nN, gid = wgid / nig, fm = gid * WGM, gsz = (nM - fm) < WGM ? (nM - fm) : WGM;
        u.pm = fm + ((wgid % nig) % gsz); u.pn = (wgid % nig) / gsz; return true;
    }
    __device__ __forceinline__ void a_ready(const Unit&) const {}
    __device__ __forceinline__ void done(const Unit&) const {}
};

struct PanelOrder { int lo, hi, nN, G, c;
    __device__ bool next(int i, Unit& u) const { const int L = lo + i * G + c; if (L >= hi) return false; u.pm = L / nN; u.pn = L - u.pm * nN; return true; }
    __device__ __forceinline__ void a_ready(const Unit&) const {}
    __device__ __forceinline__ void done(const Unit&) const {} };

struct DownOrder { int G, c;
    __device__ bool next(int i, Unit& u) const {
        int L;
        if (G == 256) { if (c < 48) { if (i > 0) return false; L = 624 + c; } else { if (i > 2) return false; L = i * 208 + (c - 48); } }
        else { L = i * G + c; if (L >= 672) return false; }
        if (L < 32) { u.pm = L >> 1; u.pn = L & 1; } else { const int l2 = L - 32; u.pm = 16 + l2 / 5; u.pn = l2 - (l2 / 5) * 5; }
        return true; }
    __device__ __forceinline__ void a_ready(const Unit&) const {}
    __device__ __forceinline__ void done(const Unit&) const {} };

struct ColBlockOrder { int nRB, nB, c, G, nN, nwg;
    __host__ __device__ void init(int M, int N, int G_, int c_) { nRB = M / (8 * BM); nB = nRB * (N / (4 * BM)); c = c_; G = G_; nN = N / BM; nwg = (M / BM) * nN; }
    __device__ bool next(int i, Unit& u) const {
        if (G != 256) { const int L = i * G + c; if (L >= nwg) return false; u.pm = L / nN; u.pn = L - u.pm * nN; return true; }
        const int x = c >> 5, idx = c & 31, q = nB / 8, r = nB % 8, start = x * q + (x < r ? x : r), cnt = q + (x < r ? 1 : 0);
        if (i >= cnt) return false;
        const int b = start + i, cb = b / nRB, rb = b - cb * nRB;
        u.pm = rb * 8 + (idx & 7); u.pn = cb * 4 + (idx >> 3); return true; }
    __device__ __forceinline__ void a_ready(const Unit&) const {}
    __device__ __forceinline__ void done(const Unit&) const {} };

__device__ __forceinline__ unsigned cvt_pk_bf16(float lo, float hi) { unsigned r; asm volatile("v_cvt_pk_bf16_f32 %0, %1, %2" : "=v"(r) : "v"(lo), "v"(hi)); return r; }
typedef float f32x2 __attribute__((ext_vector_type(2)));
__device__ __forceinline__ float silu_f(float a) { return a * __builtin_amdgcn_rcpf(1.0f + __builtin_amdgcn_exp2f(a * -1.4426950408889634f)); }
__device__ __forceinline__ int cond_of_panel(int pm) { return pm < 16 ? 0 : 1 + ((pm - 16) >> 4); }
constexpr int MODROW = 2 * 9 * 2048;

__device__ __forceinline__ float clamp448(float x) { return __builtin_fminf(__builtin_fmaxf(x, -448.0f), 448.0f); }
__device__ __forceinline__ unsigned pk4_fp8(float a, float b, float c, float d) { int p = __builtin_amdgcn_cvt_pk_fp8_f32(clamp448(a), clamp448(b), 0, false); p = __builtin_amdgcn_cvt_pk_fp8_f32(clamp448(c), clamp448(d), p, true); return (unsigned)p; }
constexpr float W13_SCALE = 64.0f, W2_SCALE = 128.0f;
struct EpiSwiGLU {
    static constexpr bool PERM = true, AFTER_DRAIN = false;
    unsigned char* O; int ldc;
    static __device__ __forceinline__ f32x2 g2(f32x2 a, f32x2 b) {
        constexpr float S = 1.0f / W13_SCALE;
        const f32x2 t = a * (-1.4426950408889634f * S); f32x2 e; e.x = __builtin_amdgcn_exp2f(t.x); e.y = __builtin_amdgcn_exp2f(t.y);
        const f32x2 d = e + 1.0f; f32x2 r; r.x = __builtin_amdgcn_rcpf(d.x); r.y = __builtin_amdgcn_rcpf(d.y);
        return (a * b) * (r * (S * S));
    }
    static __device__ __forceinline__ unsigned pk4(f32x2 lo, f32x2 hi) { int p = __builtin_amdgcn_cvt_pk_fp8_f32(lo.x, lo.y, 0, false); p = __builtin_amdgcn_cvt_pk_fp8_f32(hi.x, hi.y, p, true); return (unsigned)p; }
    __device__ __forceinline__ void operator()(const f32x4 (&acc)[2][2][4][2], const Unit& u, int wr, int wc, int fr, int fq) const {
        const int row0 = u.pm * BM + wr * 64 + fr, col0 = u.pn * HALF + wc * 32 + 8 * fq;
#pragma unroll
        for (int ai = 0; ai < 2; ++ai)
#pragma unroll
            for (int m = 0; m < 4; ++m) { unsigned char* rowp = O + (size_t)(row0 + ai * HALF + m * 16) * ldc + col0;
                const f32x4 a0 = acc[ai][0][m][0], a1 = acc[ai][0][m][1], b0 = acc[ai][1][m][0], b1 = acc[ai][1][m][1];
                typedef unsigned u32x2_t __attribute__((ext_vector_type(2)));
                u32x2_t w; w.x = pk4(g2((f32x2){a0[0], a0[1]}, (f32x2){b0[0], b0[1]}), g2((f32x2){a0[2], a0[3]}, (f32x2){b0[2], b0[3]}));
                w.y = pk4(g2((f32x2){a1[0], a1[1]}, (f32x2){b1[0], b1[1]}), g2((f32x2){a1[2], a1[3]}, (f32x2){b1[2], b1[3]}));
                *(u32x2_t*)rowp = w; }
    }
};
typedef _Float16 h16x8 __attribute__((ext_vector_type(8)));
typedef float f32x8_t __attribute__((ext_vector_type(8)));
struct EpiResid {
    static constexpr bool PERM = true, AFTER_DRAIN = false;
    bf16_t* T; const float* gate0;
    const float* stats; const float* lng; const float* lnb; double coef_d;
    static constexpr float alpha = 1.4142135623730951f;
    __device__ __forceinline__ void operator()(const f32x4 (&acc)[2][2][4][2], const Unit& u, int wr, int wc, int fr, int fq) const {
        typedef float f32x2_t __attribute__((ext_vector_type(2)));
        const int row0 = u.pm * BM + wr * 64 + fr, col0 = u.pn * BM + wc * 32 + 8 * fq;
        const float* gp = gate0 + (size_t)cond_of_panel(u.pm) * MODROW + col0; const float coef = (float)coef_d;
        const unsigned o0 = ((unsigned)row0 * 2048u + (unsigned)col0) * 2u, os0 = (unsigned)row0 * 8u;
        h16x8 hA[4], hB[4]; f32x2_t sA[4], sB[4];
#define RES_LOAD(H, S, bj, ai) do { _Pragma("unroll") for (int m = 0; m < 4; ++m) { const size_t ro = (size_t)((ai) * HALF + m * 16) * 2048 + (bj) * HALF; \
            S[m] = *(const f32x2_t*)((const char*)stats + (size_t)((ai) * HALF + m * 16) * 8 + os0); H[m] = *(const h16x8*)((const char*)(T + ro) + o0); } } while (0)
#define RES_STORE(H, S, bj, ai) do { f32x4 gv[2], G[2], B[2]; \
            _Pragma("unroll") for (int n = 0; n < 2; ++n) { const int c = col0 + (bj) * HALF + 4 * n; gv[n] = *(const f32x4*)(gp + (bj) * HALF + 4 * n) * coef; G[n] = *(const f32x4*)(lng + c) * alpha; B[n] = *(const f32x4*)(lnb + c) * alpha; } \
            _Pragma("unroll") for (int m = 0; m < 4; ++m) { const size_t ro = (size_t)((ai) * HALF + m * 16) * 2048 + (bj) * HALF; \
                const f32x8_t wf = __builtin_convertvector(H[m], f32x8_t); const f32x4 t0 = (f32x4){wf[0], wf[1], wf[2], wf[3]}, t1 = (f32x4){wf[4], wf[5], wf[6], wf[7]}; \
                const f32x4 v0 = G[0] * (t0 * S[m].x + S[m].y) + (gv[0] * acc[ai][bj][m][0] + B[0]), v1 = G[1] * (t1 * S[m].x + S[m].y) + (gv[1] * acc[ai][bj][m][1] + B[1]); \
                const f32x8_t vf = (f32x8_t){v0[0], v0[1], v0[2], v0[3], v1[0], v1[1], v1[2], v1[3]}; \
                *(h16x8*)((char*)(T + ro) + o0) = __builtin_convertvector(vf, h16x8); } } while (0)
        RES_LOAD(hA, sA, 0, 0); RES_LOAD(hB, sB, 0, 1);
        RES_STORE(hA, sA, 0, 0); RES_LOAD(hA, sA, 1, 0);
        RES_STORE(hB, sB, 0, 1); RES_LOAD(hB, sB, 1, 1);
        RES_STORE(hA, sA, 1, 0);
        RES_STORE(hB, sB, 1, 1);
#undef RES_LOAD
#undef RES_STORE
    }
};
struct EpiF32 {
    static constexpr bool PERM = false, AFTER_DRAIN = false;
    float* C; int ldc;
    __device__ __forceinline__ void operator()(const f32x4 (&acc)[2][2][4][2], const Unit& u, int wr, int wc, int fr, int fq) const {
        const int row0 = u.pm * BM + wr * 64 + fr, col0 = u.pn * BM + wc * 32 + 4 * fq;
#pragma unroll
        for (int ai = 0; ai < 2; ++ai)
#pragma unroll
            for (int m = 0; m < 4; ++m) { float* rowp = C + (size_t)(row0 + ai * HALF + m * 16) * ldc + col0;
#pragma unroll
                for (int bj = 0; bj < 2; ++bj)
#pragma unroll
                    for (int n = 0; n < 2; ++n) *(f32x4*)(rowp + bj * HALF + n * 16) = acc[ai][bj][m][n]; }
    }
};
struct EpiF16 {
    static constexpr bool PERM = true, AFTER_DRAIN = false;
    bf16_t* O; long ldc; double scale_d;
    __device__ __forceinline__ void operator()(const f32x4 (&acc)[2][2][4][2], const Unit& u, int wr, int wc, int fr, int fq) const {
        const int row0 = u.pm * BM + wr * 64 + fr, col0 = u.pn * BM + wc * 32 + 8 * fq; const float sc = (float)scale_d;
#pragma unroll
        for (int ai = 0; ai < 2; ++ai)
#pragma unroll
            for (int m = 0; m < 4; ++m) { bf16_t* rowp = O + (size_t)(row0 + ai * HALF + m * 16) * ldc + col0;
#pragma unroll
                for (int bj = 0; bj < 2; ++bj) { const f32x4 v0 = acc[ai][bj][m][0] * sc, v1 = acc[ai][bj][m][1] * sc;
                    h16x8 w = {(_Float16)v0[0], (_Float16)v0[1], (_Float16)v0[2], (_Float16)v0[3], (_Float16)v1[0], (_Float16)v1[1], (_Float16)v1[2], (_Float16)v1[3]};
                    *(h16x8*)(rowp + bj * HALF) = w; } }
    }
};
struct EpiBf16 {
    static constexpr bool PERM = true, AFTER_DRAIN = false;
    bf16_t* O; long ldc; long split_cols; size_t split_stride; double scale_d; long skip_panels;
    __device__ __forceinline__ void operator()(const f32x4 (&acc)[2][2][4][2], const Unit& u, int wr, int wc, int fr, int fq) const {
        const int row0 = u.pm * BM + wr * 64 + fr; int colt = u.pn * BM; bf16_t* base = O; int t = 0; const float sc = (float)scale_d;
        if (split_cols) { t = colt / (int)split_cols; base += (size_t)t * split_stride; colt -= t * (int)split_cols; }
        if (u.pm < (int)skip_panels && (t == 1 || t == 2)) return;
        const int col0 = colt + wc * 32 + 8 * fq;
#pragma unroll
        for (int ai = 0; ai < 2; ++ai)
#pragma unroll
            for (int m = 0; m < 4; ++m) { bf16_t* rowp = base + (size_t)(row0 + ai * HALF + m * 16) * ldc + col0;
#pragma unroll
                for (int bj = 0; bj < 2; ++bj) { const f32x4 v0 = acc[ai][bj][m][0] * sc, v1 = acc[ai][bj][m][1] * sc;
                    u32x4 w; w.x = cvt_pk_bf16(v0[0], v0[1]); w.y = cvt_pk_bf16(v0[2], v0[3]); w.z = cvt_pk_bf16(v1[0], v1[1]); w.w = cvt_pk_bf16(v1[2], v1[3]);
                    *(u32x4*)(rowp + bj * HALF) = w; } }
    }
};
struct EpiQRope {
    static constexpr bool PERM = true, AFTER_DRAIN = false;
    unsigned char* O; long tab_lds;
    __device__ __forceinline__ void operator()(const f32x4 (&acc)[2][2][4][2], const Unit& u, int wr, int wc, int fr, int fq) const {
        const int row0 = u.pm * BM + wr * 64 + fr, col0 = u.pn * BM + wc * 32 + 8 * fq;
        const bool lat = u.pm >= 16; const int prow_base = ((u.pm - 16) & 15) * 4 + wr;
#pragma unroll
        for (int bj = 0; bj < 2; ++bj) { const int grp = u.pn * 8 + bj * 4 + wc, gi = grp % 6;
            const bool rot = lat && gi >= 4;
            f32x4 tc[4], ts[4];
            if (rot) {
#pragma unroll
                for (int k = 0; k < 4; ++k) { const int pos = (gi == 4) ? (prow_base + 2 * (k & 1)) : (16 * k + fr);
                    typedef __attribute__((address_space(3))) const f32x4 LF4; LF4* tp = (LF4*)(unsigned)((unsigned)tab_lds + (unsigned)((pos * 16 + 4 * fq) * 8)); const f32x4 t0 = tp[0], t1 = tp[1];
                    tc[k] = (f32x4){t0[0], t0[2], t1[0], t1[2]}; ts[k] = (f32x4){t0[1], t0[3], t1[1], t1[3]}; }
            }
#pragma unroll
            for (int ai = 0; ai < 2; ++ai)
#pragma unroll
                for (int m = 0; m < 4; ++m) { f32x4 v0 = acc[ai][bj][m][0] * (1.0f / 32.0f), v1 = acc[ai][bj][m][1] * (1.0f / 32.0f);
                    if (rot) { const int k = (gi == 4) ? ai : m; const f32x4 cs = tc[k], sn = ts[k], x1 = v0, x2 = v1; v0 = x1 * cs - x2 * sn; v1 = x2 * cs + x1 * sn; }
                    typedef unsigned u32x2_t __attribute__((ext_vector_type(2)));
                    u32x2_t w; w.x = pk4_fp8(v0[0], v0[1], v0[2], v0[3]); w.y = pk4_fp8(v1[0], v1[1], v1[2], v1[3]);
                    *(u32x2_t*)(O + (size_t)(row0 + ai * HALF + m * 16) * 3072 + col0 + bj * HALF) = w; } }
    }
};
struct EpiKV8 {
    static constexpr bool PERM = true, AFTER_DRAIN = false;
    unsigned char* K8; unsigned char* VT; double scale_d;
    __device__ __forceinline__ void operator()(const f32x4 (&acc)[2][2][4][2], const Unit& u, int wr, int wc, int fr, int fq) const {
        typedef unsigned u32x2_t __attribute__((ext_vector_type(2)));
        const float sc = (float)scale_d;
        const int row0 = u.pm * BM + wr * 64 + fr, col0 = u.pn * HALF + wc * 32 + 8 * fq;
        unsigned char* kp = K8 + (size_t)row0 * 2048 + col0;
        const int q = fr & 3; unsigned char* vp = VT + (size_t)(col0 + q) * 38912 + (row0 - q);
        const unsigned sel1 = (q & 1) ? 0x03070105u : 0x06020400u, sel2 = (q & 2) ? 0x03020706u : 0x05040100u;
#pragma unroll
        for (int ai = 0; ai < 2; ++ai)
#pragma unroll
            for (int m = 0; m < 4; ++m) { const int rs = ai * HALF + m * 16;
                const f32x4 k0 = acc[ai][0][m][0] * sc, k1 = acc[ai][0][m][1] * sc, v0 = acc[ai][1][m][0] * sc, v1 = acc[ai][1][m][1] * sc;
                u32x2_t wk; wk.x = pk4_fp8(k0[0], k0[1], k0[2], k0[3]); wk.y = pk4_fp8(k1[0], k1[1], k1[2], k1[3]); *(u32x2_t*)(kp + (size_t)rs * 2048) = wk;
                const unsigned w0 = pk4_fp8(v0[0], v0[1], v0[2], v0[3]), w1 = pk4_fp8(v1[0], v1[1], v1[2], v1[3]);
#pragma unroll
                for (int hf = 0; hf < 2; ++hf) { const unsigned w = hf ? w1 : w0;
                    const unsigned x = __builtin_amdgcn_perm((unsigned)__builtin_amdgcn_mov_dpp((int)w, 0xB1, 0xF, 0xF, true), w, sel1);
                    const unsigned y = __builtin_amdgcn_perm((unsigned)__builtin_amdgcn_mov_dpp((int)x, 0x4E, 0xF, 0xF, true), x, sel2);
                    *(unsigned*)(vp + (size_t)(4 * hf) * 38912 + rs) = y; } }
    }
};


template <class Epi, class Sched, bool ALIGN_EPI = false, bool SP2 = false, bool F8 = false>
__device__ __forceinline__ void gemm_phase(PG8_LAS unsigned char* lds, const Gemm g, const Sched& S, const Epi& E, const int wid0) {
    int wid_ = wid0; asm volatile("" : "+s"(wid_));
    const int wid = wid_, lane = hw_lane(), tid = wid * 64 + lane, wr = wid >> 2, wc = wid & 3, fr = lane & 15, fq = lane >> 4;
    const int K = g.K, nt = K / BK;
    unsigned voffA[1], voffB[1];
    { int R, C; stage_rc(tid * 16, R, C); const int Rb = Epi::PERM ? ((R & ~31) + perm32(R & 31)) : R;
        voffA[0] = (unsigned)(R * K + C) * 2u; voffB[0] = (unsigned)(Rb * K + C) * 2u; }
    const size_t piece2 = (size_t)64 * K * 2;
    const size_t kstep = (size_t)(BK * 2);
    const size_t hstep = (size_t)HALF * K * 2;
    const size_t tstep = 2 * hstep;
    const unsigned ldsbase_u = __builtin_amdgcn_readfirstlane((unsigned)(unsigned long long)lds);
    const unsigned ldsw = (unsigned)wid * 1024u;
    const int aoff = lds_byte(wr * 64 + fr, fq * 8), boff = lds_byte(wc * 32 + fr, fq * 8);
    PG8_LAS unsigned char* abase = lds + aoff; PG8_LAS unsigned char* bbase = lds + 4 * HTB + boff; asm volatile("" : "+v"(abase), "+v"(bbase));
#define PG8_SA(b, h) (((b) * 2 + (h)) * HTB)
#define PG8_SB(b, h) ((4 + (b) * 2 + (h)) * HTB)
#define PG8_STAGE(bufoff, gbase, voff) do { _Pragma("unroll") for (int _i = 0; _i < 2; ++_i) { const unsigned long long gb_ = (unsigned long long)(gbase) + (unsigned long long)_i * piece2; \
        const unsigned glo_ = __builtin_amdgcn_readfirstlane((unsigned)gb_), ghi_ = __builtin_amdgcn_readfirstlane((unsigned)(gb_ >> 32)); const unsigned long long gs_ = ((unsigned long long)ghi_ << 32) | glo_; unsigned keep_; \
        asm volatile("s_mov_b32 %0, m0\n\ts_mov_b32 m0, %3\n\ts_nop 0\n\tglobal_load_lds_dwordx4 %1, %2\n\ts_mov_b32 m0, %0" : "=&s"(keep_) : "v"((voff)[0]), "s"(gs_), "s"(ldsbase_u + (unsigned)(bufoff) + ldsw + _i * 8192u) : "memory"); } } while (0)
#define PG8_LD16A(off) (*(const PG8_LAS bf16x8*)(abase + (off)))
#define PG8_LD16B(off) (*(const PG8_LAS bf16x8*)(bbase + (off)))
#define PG8_CAT8(x, y) __builtin_shufflevector(__builtin_bit_cast(v4i_t, x), __builtin_bit_cast(v4i_t, y), 0, 1, 2, 3, 4, 5, 6, 7)
#define PG8_LDA(dst, b, h) do { if constexpr (F8) { _Pragma("unroll") for (int m = 0; m < 4; ++m) dst##8[m] = PG8_CAT8(PG8_LD16A(PG8_SA(b, h) + m * 2048), PG8_LD16A(PG8_SA(b, h) + m * 2048 + 1024)); } \
    else { _Pragma("unroll") for (int m = 0; m < 4; ++m) _Pragma("unroll") for (int k = 0; k < 2; ++k) dst[m][k] = PG8_LD16A(PG8_SA(b, h) + m * 2048 + k * 1024); } } while (0)
#define PG8_LDB(dst, b, h) do { if constexpr (F8) { _Pragma("unroll") for (int n = 0; n < 2; ++n) dst##8[n] = PG8_CAT8(PG8_LD16B(PG8_SB(b, h) - 4 * HTB + n * 2048), PG8_LD16B(PG8_SB(b, h) - 4 * HTB + n * 2048 + 1024)); } \
    else { _Pragma("unroll") for (int n = 0; n < 2; ++n) _Pragma("unroll") for (int k = 0; k < 2; ++k) dst[n][k] = PG8_LD16B(PG8_SB(b, h) - 4 * HTB + n * 2048 + k * 1024); } } while (0)
#define PG8_MMA(ai, bj, At, Bt) do { __builtin_amdgcn_s_setprio(1); if constexpr (F8) { _Pragma("unroll") for (int m = 0; m < 4; ++m) _Pragma("unroll") for (int n = 0; n < 2; ++n) \
        acc[ai][bj][m][n] = __builtin_amdgcn_mfma_scale_f32_16x16x128_f8f6f4(Bt##8[n], At##8[m], acc[ai][bj][m][n], 0, 0, 0, 0, 0, 0); } \
    else { _Pragma("unroll") for (int m = 0; m < 4; ++m) _Pragma("unroll") for (int n = 0; n < 2; ++n) _Pragma("unroll") for (int k = 0; k < 2; ++k) \
        acc[ai][bj][m][n] = __builtin_amdgcn_mfma_f32_16x16x32_bf16(Bt[n][k], At[m][k], acc[ai][bj][m][n], 0, 0, 0); } __builtin_amdgcn_s_setprio(0); } while (0)
#define PG8_WAIT_V(n) asm volatile("s_waitcnt vmcnt(" #n ")" ::: "memory")
#define PG8_WAIT_L(n) asm volatile("s_waitcnt lgkmcnt(" #n ")" ::: "memory")
#define PG8_BAR __builtin_amdgcn_s_barrier()
#define PG8_SCHED __builtin_amdgcn_sched_barrier(0)
    Unit cur, nxt; int ui = 0;
    if (!S.next(0, cur)) return;
    f32x4 acc[2][2][4][2];
#pragma unroll
    for (int a = 0; a < 2; ++a)
#pragma unroll
        for (int b = 0; b < 2; ++b)
#pragma unroll
            for (int m = 0; m < 4; ++m)
#pragma unroll
                for (int n = 0; n < 2; ++n) acc[a][b][m][n] = (f32x4){0.f, 0.f, 0.f, 0.f};
    bf16x8 At[4][2], B0[2][2], B1[2][2]; v8i_t At8[4], B08[2], B18[2];
    const char* cA = (const char*)g.A + (size_t)cur.pm * tstep; const char* cB = (const char*)g.Bt + (size_t)cur.pn * tstep;
    S.a_ready(cur);
    if constexpr (SP2) {
        PG8_STAGE(PG8_SB(0, 0), cB, voffB); PG8_STAGE(PG8_SB(0, 1), cB + hstep, voffB); PG8_STAGE(PG8_SA(0, 0), cA, voffA); PG8_STAGE(PG8_SA(0, 1), cA + hstep, voffA);
        if (wr == 1) PG8_BAR;
        PG8_WAIT_V(2); PG8_BAR;
        PG8_STAGE(PG8_SB(1, 0), cB + kstep, voffB); PG8_STAGE(PG8_SA(1, 0), cA + kstep, voffA); PG8_STAGE(PG8_SB(1, 1), cB + hstep + kstep, voffB);
        PG8_WAIT_V(6); PG8_BAR;
    } else {
        PG8_STAGE(PG8_SB(0, 0), cB, voffB); PG8_STAGE(PG8_SA(0, 0), cA, voffA); PG8_STAGE(PG8_SB(0, 1), cB + hstep, voffB); PG8_STAGE(PG8_SA(0, 1), cA + hstep, voffA);
        if (wr == 1) PG8_BAR;
        PG8_WAIT_V(4); PG8_BAR;
        PG8_STAGE(PG8_SB(1, 0), cB + kstep, voffB); PG8_STAGE(PG8_SA(1, 0), cA + kstep, voffA); PG8_STAGE(PG8_SB(1, 1), cB + hstep + kstep, voffB);
        PG8_WAIT_V(6); PG8_BAR;
    }
    for (;;) {
        const bool has_next = S.next(ui + 1, nxt);
        const char* nA = has_next ? (const char*)g.A + (size_t)nxt.pm * tstep : cA; const char* nB = has_next ? (const char*)g.Bt + (size_t)nxt.pn * tstep : cB;
#pragma unroll 1
        for (int t = 0; t < nt; t += 2) {
            const bool last = (t == nt - 2);
            const char* a1 = cA + (size_t)(t + 1) * kstep;
            const char* a2 = last ? nA : cA + (size_t)(t + 2) * kstep; const char* b2 = last ? nB : cB + (size_t)(t + 2) * kstep;
            const char* a3 = a2 + kstep; const char* b3 = b2 + kstep;
            if (last && has_next) S.a_ready(nxt);
            if constexpr (SP2) {
            PG8_LDB(B0, 0, 0); PG8_LDB(B1, 0, 1); PG8_SCHED; PG8_LDA(At, 0, 0); PG8_STAGE(PG8_SA(1, 1), a1 + hstep, voffA);
            PG8_WAIT_V(8); PG8_WAIT_L(0); PG8_BAR; PG8_MMA(0, 0, At, B0); PG8_MMA(0, 1, At, B1); PG8_BAR; PG8_SCHED;
            PG8_LDA(At, 0, 1); PG8_STAGE(PG8_SB(0, 0), b2, voffB); PG8_STAGE(PG8_SB(0, 1), b2 + hstep, voffB); PG8_STAGE(PG8_SA(0, 0), a2, voffA);
            PG8_WAIT_V(8); PG8_WAIT_L(0); PG8_BAR; PG8_MMA(1, 0, At, B0); PG8_MMA(1, 1, At, B1); PG8_BAR; PG8_SCHED;
            PG8_LDB(B0, 1, 0); PG8_LDB(B1, 1, 1); PG8_SCHED; PG8_LDA(At, 1, 0); PG8_STAGE(PG8_SA(0, 1), a2 + hstep, voffA);
            PG8_WAIT_V(8); PG8_WAIT_L(0); PG8_BAR; PG8_MMA(0, 0, At, B0); PG8_MMA(0, 1, At, B1); PG8_BAR; PG8_SCHED;
            PG8_LDA(At, 1, 1); PG8_STAGE(PG8_SB(1, 0), b3, voffB); PG8_STAGE(PG8_SB(1, 1), b3 + hstep, voffB); PG8_STAGE(PG8_SA(1, 0), a3, voffA);
            PG8_WAIT_V(8); PG8_WAIT_L(0); PG8_BAR; PG8_MMA(1, 0, At, B0); PG8_MMA(1, 1, At, B1); PG8_BAR; PG8_SCHED;
            } else {
            PG8_LDB(B0, 0, 0); PG8_SCHED; PG8_LDA(At, 0, 0); PG8_STAGE(PG8_SA(1, 1), a1 + hstep, voffA);
            PG8_WAIT_L(8); PG8_BAR; PG8_WAIT_L(0); PG8_MMA(0, 0, At, B0); PG8_BAR; PG8_SCHED;
            PG8_LDB(B1, 0, 1); PG8_STAGE(PG8_SB(0, 0), b2, voffB);
            PG8_BAR; PG8_WAIT_L(0); PG8_MMA(0, 1, At, B1); PG8_BAR;
            PG8_LDA(At, 0, 1); PG8_STAGE(PG8_SA(0, 0), a2, voffA);
            PG8_BAR; PG8_WAIT_L(0); PG8_MMA(1, 0, At, B0); PG8_BAR; PG8_SCHED;
            PG8_STAGE(PG8_SB(0, 1), b2 + hstep, voffB);
            PG8_WAIT_V(6); PG8_BAR; PG8_MMA(1, 1, At, B1); PG8_BAR;
            PG8_LDB(B0, 1, 0); PG8_SCHED; PG8_LDA(At, 1, 0); PG8_STAGE(PG8_SA(0, 1), a2 + hstep, voffA);
            PG8_WAIT_L(8); PG8_BAR; PG8_WAIT_L(0); PG8_MMA(0, 0, At, B0); PG8_BAR; PG8_SCHED;
            PG8_LDB(B1, 1, 1); PG8_STAGE(PG8_SB(1, 0), b3, voffB);
            PG8_BAR; PG8_WAIT_L(0); PG8_MMA(0, 1, At, B1); PG8_BAR;
            PG8_LDA(At, 1, 1); PG8_STAGE(PG8_SA(1, 0), a3, voffA);
            PG8_BAR; PG8_WAIT_L(0); PG8_MMA(1, 0, At, B0); PG8_BAR; PG8_SCHED;
            PG8_STAGE(PG8_SB(1, 1), b3 + hstep, voffB);
            PG8_WAIT_V(6); PG8_BAR; PG8_MMA(1, 1, At, B1); PG8_BAR;
            }
        }
        if constexpr (ALIGN_EPI) { if (wr == 0) PG8_BAR; }
        if constexpr (!Epi::AFTER_DRAIN) { const int l2_ = hw_lane();
            E(acc, cur, wr, wc, l2_ & 15, l2_ >> 4); S.done(cur); }
        if (!has_next) break;
#pragma unroll
        for (int a = 0; a < 2; ++a)
#pragma unroll
            for (int b = 0; b < 2; ++b)
#pragma unroll
                for (int m = 0; m < 4; ++m)
#pragma unroll
                    for (int n = 0; n < 2; ++n) acc[a][b][m][n] = (f32x4){0.f, 0.f, 0.f, 0.f};
        cur = nxt; cA = nA; cB = nB; ++ui;
        if constexpr (ALIGN_EPI) { if (wr == 1) PG8_BAR; }
    }
    PG8_WAIT_V(0);
    if constexpr (!ALIGN_EPI) { if (wr == 0) PG8_BAR; }
    PG8_BAR;
    if constexpr (Epi::AFTER_DRAIN) { E.fused(acc, cur, wr, wc, fr, fq, lds, wid, lane); S.done(cur); }
#undef PG8_SA
#undef PG8_SB
#undef PG8_STAGE
#undef PG8_LDA
#undef PG8_LDB
#undef PG8_MMA
#undef PG8_CAT8
#undef PG8_LD16A
#undef PG8_LD16B
#undef PG8_WAIT_V
#undef PG8_WAIT_L
#undef PG8_BAR
#undef PG8_SCHED
}
}
namespace att {
using bf16x8 = __attribute__((ext_vector_type(8))) short;
using s16x4  = __attribute__((ext_vector_type(4))) short;
using f32x16 = __attribute__((ext_vector_type(16))) float;
using u32x4  = __attribute__((ext_vector_type(4))) unsigned;
typedef unsigned short bf16;
constexpr int NW = 8, QBLK = 32, KVBLK = 64;
constexpr int VT_PITCH = 38912;
constexpr float O_SCALE = 16.0f;
constexpr float THR_L2 = 11.5f;
constexpr int SHM_V = KVBLK * 128 * 2, SHM_K = KVBLK * 128 * 2, SHM_KR = KVBLK * 64 * 2;
constexpr int OFF_V = 0, OFF_K = 3 * SHM_V, OFF_KR = OFF_K + 3 * SHM_K, OFF_WS = OFF_KR + 3 * SHM_KR, OFF_RPB = OFF_WS + NW * 64 * 4 + 1024, ATT_LDS = OFF_RPB + 512 * 4 + 1024;
#define KSWZ(row, colB) ((row) * 256 + ((colB) ^ (((row) & 15) << 4)))
#define KRSWZ(row, c16) ((row) * 128 + ((((c16) ^ (((row) >> 1) & 7))) << 4))
#define SBAR() __builtin_amdgcn_sched_barrier(0)
__device__ __forceinline__ int crow(int r, int hi) { return (r & 3) + 8 * (r >> 2) + 4 * hi; }
__device__ __forceinline__ unsigned cvtpk(float lo, float hi) { unsigned r; asm volatile("v_cvt_pk_bf16_f32 %0, %1, %2" : "=v"(r) : "v"(lo), "v"(hi)); return r; }

template <bool PRE, bool LOWTHR = false, bool NOEXP = false> __device__ __forceinline__ void partialSM(f32x16& p0, f32x16& p1, float& m_reg, float& mn, float& alpha, const float C) {
  constexpr float THR = LOWTHR ? 8.0f : THR_L2;
  float pmax = p0[0];
#pragma unroll
  for (int r = 1; r < 16; ++r) pmax = fmaxf(pmax, p0[r]);
#pragma unroll
  for (int r = 0; r < 16; ++r) pmax = fmaxf(pmax, p1[r]);
  { auto rr = __builtin_amdgcn_permlane32_swap(__float_as_uint(pmax), __float_as_uint(pmax), false, false);
    pmax = fmaxf(__uint_as_float(rr[0]), __uint_as_float(rr[1])); }
  const float CC = PRE ? 1.0f : C;
  if (__builtin_expect(__all((pmax - m_reg) * CC <= THR), 1)) { mn = m_reg; alpha = 1.f; }
  else { mn = fmaxf(m_reg, pmax); alpha = __builtin_amdgcn_exp2f((m_reg - mn) * CC); m_reg = mn; }
  const float mnC = -mn * CC;
#pragma unroll
  for (int r = 0; r < 16; ++r) p0[r] = PRE ? (p0[r] + mnC) : fmaf(p0[r], CC, mnC);
#pragma unroll
  for (int r = 0; r < 16; ++r) p1[r] = PRE ? (p1[r] + mnC) : fmaf(p1[r], CC, mnC);
#pragma unroll
  for (int r = 0; r < 16; ++r) p0[r] = NOEXP ? p0[r] : __builtin_amdgcn_exp2f(p0[r]);
}
__device__ __forceinline__ void finishSM(f32x16& p0, f32x16& p1, float alpha, float& l_reg, bf16x8& pa0, bf16x8& pa1, bf16x8& pa2, bf16x8& pa3) {
#pragma unroll
  for (int r = 0; r < 16; ++r) p1[r] = __builtin_amdgcn_exp2f(p1[r]);
  float ps = 0;
#pragma unroll
  for (int r = 0; r < 16; ++r) ps += p0[r];
#pragma unroll
  for (int r = 0; r < 16; ++r) ps += p1[r];
  { auto rr = __builtin_amdgcn_permlane32_swap(__float_as_uint(ps), __float_as_uint(ps), false, false);
    ps = __uint_as_float(rr[0]) + __uint_as_float(rr[1]); }
  l_reg = l_reg * alpha + ps;
#define PK4(P, BASE, OUT) do { unsigned a0 = cvtpk(P[BASE + 0], P[BASE + 1]), a1 = cvtpk(P[BASE + 2], P[BASE + 3]);   \
    unsigned b0 = cvtpk(P[BASE + 4], P[BASE + 5]), b1 = cvtpk(P[BASE + 6], P[BASE + 7]);                              \
    auto r0 = __builtin_amdgcn_permlane32_swap(a0, b0, false, false); auto r1 = __builtin_amdgcn_permlane32_swap(a1, b1, false, false); \
    u32x4 w = {r0[0], r1[0], r0[1], r1[1]}; OUT = *reinterpret_cast<bf16x8*>(&w); } while (0)
  PK4(p0, 0, pa0); PK4(p0, 8, pa1); PK4(p1, 0, pa2); PK4(p1, 8, pa3);
#undef PK4
}
template <int ND0> __device__ __forceinline__ void qkt(f32x16& p0, f32x16& p1, const char* Ks, const char* KRs, const bf16x8* qr, int r32, int hi) {
  p0 = f32x16{}; p1 = f32x16{};
#pragma unroll
  for (int d0 = 0; d0 < 8; ++d0) { const int cb = (d0 * 16 + hi * 8) * 2;
    const bf16x8 b0 = *reinterpret_cast<const bf16x8*>(Ks + KSWZ(r32, cb));
    const bf16x8 b1 = *reinterpret_cast<const bf16x8*>(Ks + KSWZ(32 + r32, cb));
    p0 = __builtin_amdgcn_mfma_f32_32x32x16_bf16(b0, qr[d0], p0, 0, 0, 0);
    p1 = __builtin_amdgcn_mfma_f32_32x32x16_bf16(b1, qr[d0], p1, 0, 0, 0); }
  if constexpr (ND0 > 8) {
#pragma unroll
    for (int d0 = 8; d0 < ND0; ++d0) { const int c16 = (d0 - 8) * 2 + hi;
      const bf16x8 b0 = *reinterpret_cast<const bf16x8*>(KRs + KRSWZ(r32, c16));
      const bf16x8 b1 = *reinterpret_cast<const bf16x8*>(KRs + KRSWZ(32 + r32, c16));
      p0 = __builtin_amdgcn_mfma_f32_32x32x16_bf16(b0, qr[d0], p0, 0, 0, 0);
      p1 = __builtin_amdgcn_mfma_f32_32x32x16_bf16(b1, qr[d0], p1, 0, 0, 0); }
  }
}
__device__ __forceinline__ int v_st(int k, int c) { const int kk = (k & ~0xC) | ((k & 4) << 1) | ((k & 8) >> 1); return ((kk >> 3) * 4 + (c >> 5)) * 512 + ((kk & 7) * 32 + (c & 31)) * 2; }
__device__ __forceinline__ int v_rd_base(int lane) { return ((lane & 3) << 3) | (((lane >> 2) & 3) << 6) | (((lane >> 4) & 1) << 5) | (((lane >> 5) & 1) << 8); }
constexpr int v_rd_off(int d0, int ks, int half) { return d0 * 512 + ks * 4096 + half * 2048; }
template <int OFF> __device__ __forceinline__ s16x4 tr_read(int vb) {
  s16x4 r; asm volatile("ds_read_b64_tr_b16 %0, %1 offset:%2" : "=&v"(r) : "v"(vb), "i"(OFF) : "memory"); return r;
}
struct VFrag { s16x4 l0, h0, l1, h1, l2, h2, l3, h3; };
template <int D0> __device__ __forceinline__ void v_reads(VFrag& f, int vb) {
  f.l0 = tr_read<v_rd_off(D0, 0, 0)>(vb); f.h0 = tr_read<v_rd_off(D0, 0, 1)>(vb); f.l1 = tr_read<v_rd_off(D0, 1, 0)>(vb); f.h1 = tr_read<v_rd_off(D0, 1, 1)>(vb);
  f.l2 = tr_read<v_rd_off(D0, 2, 0)>(vb); f.h2 = tr_read<v_rd_off(D0, 2, 1)>(vb); f.l3 = tr_read<v_rd_off(D0, 3, 0)>(vb); f.h3 = tr_read<v_rd_off(D0, 3, 1)>(vb);
}
__device__ __forceinline__ void pv_mma(f32x16& od, const VFrag& f, bf16x8 pa0, bf16x8 pa1, bf16x8 pa2, bf16x8 pa3) {
#define PK(L, H) (bf16x8){L[0], L[1], L[2], L[3], H[0], H[1], H[2], H[3]}
  od = __builtin_amdgcn_mfma_f32_32x32x16_bf16(pa0, PK(f.l0, f.h0), od, 0, 0, 0);
  od = __builtin_amdgcn_mfma_f32_32x32x16_bf16(pa1, PK(f.l1, f.h1), od, 0, 0, 0);
  od = __builtin_amdgcn_mfma_f32_32x32x16_bf16(pa2, PK(f.l2, f.h2), od, 0, 0, 0);
  od = __builtin_amdgcn_mfma_f32_32x32x16_bf16(pa3, PK(f.l3, f.h3), od, 0, 0, 0);
#undef PK
}
__device__ __forceinline__ void pv_d0(f32x16* o, int vb, bf16x8 pa0, bf16x8 pa1, bf16x8 pa2, bf16x8 pa3) {
  VFrag fa, fb;
  v_reads<0>(fa, vb); v_reads<1>(fb, vb);
  asm volatile("s_waitcnt lgkmcnt(8)" ::: "memory"); SBAR(); pv_mma(o[0], fa, pa0, pa1, pa2, pa3); SBAR();
  v_reads<2>(fa, vb);
  asm volatile("s_waitcnt lgkmcnt(8)" ::: "memory"); SBAR(); pv_mma(o[1], fb, pa0, pa1, pa2, pa3); SBAR();
  v_reads<3>(fb, vb);
  asm volatile("s_waitcnt lgkmcnt(8)" ::: "memory"); SBAR(); pv_mma(o[2], fa, pa0, pa1, pa2, pa3); SBAR();
  asm volatile("s_waitcnt lgkmcnt(0)" ::: "memory"); SBAR(); pv_mma(o[3], fb, pa0, pa1, pa2, pa3);
}

template <int OFF> __device__ __forceinline__ bf16x8 lds_read16(int addr) { bf16x8 r; asm volatile("ds_read_b128 %0, %1 offset:%2" : "=&v"(r) : "v"(addr), "i"(OFF) : "memory"); return r; }
template <int D, int HALF> __device__ __forceinline__ bf16x8 kread(const int (&kbs)[8], const int (&krbs)[4]) {
  if constexpr (D < 8) return lds_read16<HALF * 8192>(kbs[D]); else return lds_read16<HALF * 4096>(krbs[D - 8]);
}
#define LGKM(n) asm volatile("s_waitcnt lgkmcnt(" #n ")" ::: "memory")
template <int ND0, int D> struct KStep {
  static __device__ __forceinline__ void run(f32x16& p0, f32x16& p1, bf16x8 (&kf0)[4], bf16x8 (&kf1)[4], const int (&kbs)[8], const int (&krbs)[4], const bf16x8* qr, VFrag& fa, int vb) {
    constexpr int R = (ND0 - 1 - D) < 3 ? (ND0 - 1 - D) : 3;
    constexpr bool VIN = D >= ND0 - 3;
    constexpr int CNT = 2 * R + (VIN ? 8 : 0);
    if constexpr (CNT == 6) LGKM(6); else if constexpr (CNT == 12) LGKM(12); else if constexpr (CNT == 10) LGKM(10); else LGKM(8);
    SBAR();
    p0 = __builtin_amdgcn_mfma_f32_32x32x16_bf16(kf0[D & 3], qr[D], p0, 0, 0, 0);
    p1 = __builtin_amdgcn_mfma_f32_32x32x16_bf16(kf1[D & 3], qr[D], p1, 0, 0, 0);
    SBAR();
    if constexpr (D + 4 < ND0) { kf0[D & 3] = kread<D + 4, 0>(kbs, krbs); kf1[D & 3] = kread<D + 4, 1>(kbs, krbs); }
    if constexpr (D == ND0 - 4) v_reads<0>(fa, vb);
    if constexpr (D + 1 < ND0) KStep<ND0, D + 1>::run(p0, p1, kf0, kf1, kbs, krbs, qr, fa, vb);
  }
};
template <int ND0> __device__ __forceinline__ void x_phase(f32x16& p0, f32x16& p1, f32x16* o, const int (&kbs)[8], const int (&krbs)[4], const bf16x8* qr, int vb, bool do_pv,
                                                           bf16x8 pa0, bf16x8 pa1, bf16x8 pa2, bf16x8 pa3) {
  static_assert(ND0 == 8 || ND0 == 12, "window arithmetic written for 8 or 12 k-steps");
  bf16x8 kf0[4], kf1[4]; VFrag fa, fb;
  p0 = f32x16{}; p1 = f32x16{};
  kf0[0] = kread<0, 0>(kbs, krbs); kf1[0] = kread<0, 1>(kbs, krbs); kf0[1] = kread<1, 0>(kbs, krbs); kf1[1] = kread<1, 1>(kbs, krbs);
  kf0[2] = kread<2, 0>(kbs, krbs); kf1[2] = kread<2, 1>(kbs, krbs); kf0[3] = kread<3, 0>(kbs, krbs); kf1[3] = kread<3, 1>(kbs, krbs);
  KStep<ND0, 0>::run(p0, p1, kf0, kf1, kbs, krbs, qr, fa, vb);
  v_reads<1>(fb, vb);
  LGKM(8); SBAR(); if (do_pv) pv_mma(o[0], fa, pa0, pa1, pa2, pa3); SBAR();
  v_reads<2>(fa, vb);
  LGKM(8); SBAR(); if (do_pv) pv_mma(o[1], fb, pa0, pa1, pa2, pa3); SBAR();
  v_reads<3>(fb, vb);
  LGKM(8); SBAR(); if (do_pv) pv_mma(o[2], fa, pa0, pa1, pa2, pa3); SBAR();
  LGKM(0); SBAR(); if (do_pv) pv_mma(o[3], fb, pa0, pa1, pa2, pa3); SBAR();
}
typedef int v8i_a __attribute__((ext_vector_type(8))); typedef int v4i_a __attribute__((ext_vector_type(4)));
#define CAT8A(x, y) __builtin_shufflevector(__builtin_bit_cast(v4i_a, x), __builtin_bit_cast(v4i_a, y), 0, 1, 2, 3, 4, 5, 6, 7)
struct KFrag8 { bf16x8 a0l, a0h, a1l, a1h; };
template <int KB> __device__ __forceinline__ void k8_reads(KFrag8& f, const int (&k8b)[2][2], const int (&kr8b)[2]) {
  if constexpr (KB < 2) { f.a0l = lds_read16<0>(k8b[KB][0]); f.a0h = lds_read16<0>(k8b[KB][1]); f.a1l = lds_read16<4096>(k8b[KB][0]); f.a1h = lds_read16<4096>(k8b[KB][1]); }
  else { f.a0l = lds_read16<0>(kr8b[0]); f.a0h = lds_read16<0>(kr8b[1]); f.a1l = lds_read16<2048>(kr8b[0]); f.a1h = lds_read16<2048>(kr8b[1]); }
}
template <bool NOMMA = false> __device__ __forceinline__ void k8_mma(f32x16& p0, f32x16& p1, const KFrag8& f, v8i_a q) {
  if constexpr (NOMMA) { asm volatile("" :: "v"(f.a0l), "v"(f.a0h), "v"(f.a1l), "v"(f.a1h)); return; }
  p0 = __builtin_amdgcn_mfma_scale_f32_32x32x64_f8f6f4(CAT8A(f.a0l, f.a0h), q, p0, 0, 0, 0, 0, 0, 0);
  p1 = __builtin_amdgcn_mfma_scale_f32_32x32x64_f8f6f4(CAT8A(f.a1l, f.a1h), q, p1, 0, 0, 0, 0, 0, 0);
}
struct VFrag8 { bf16x8 lo, hi_; };
template <int D0> __device__ __forceinline__ void vt_reads(VFrag8& f, const int (&vtb)[2]) { f.lo = lds_read16<D0 * 2048>(vtb[0]); f.hi_ = lds_read16<D0 * 2048>(vtb[1]); }
template <bool NOMMA = false> __device__ __forceinline__ void x_phase8(f32x16& p0, f32x16& p1, f32x16* o, const int (&k8b)[2][2], const int (&kr8b)[2], const v8i_a (&q8)[3], const int (&vtb)[2], bool do_pv, v8i_a pa8) {
  KFrag8 ka, kb; VFrag8 va, vb_;
  p0 = f32x16{}; p1 = f32x16{};
  k8_reads<0>(ka, k8b, kr8b); k8_reads<1>(kb, k8b, kr8b);
  LGKM(4); SBAR(); k8_mma<NOMMA>(p0, p1, ka, q8[0]); SBAR();
  k8_reads<2>(ka, k8b, kr8b);
  LGKM(4); SBAR(); k8_mma<NOMMA>(p0, p1, kb, q8[1]); SBAR();
  vt_reads<0>(va, vtb); vt_reads<1>(vb_, vtb);
  LGKM(4); SBAR(); k8_mma<NOMMA>(p0, p1, ka, q8[2]); SBAR();
  LGKM(2); SBAR(); if constexpr (NOMMA) asm volatile("" :: "v"(va.lo), "v"(va.hi_)); else if (do_pv) o[0] = __builtin_amdgcn_mfma_scale_f32_32x32x64_f8f6f4(pa8, CAT8A(va.lo, va.hi_), o[0], 0, 0, 0, 0, 0, 0); SBAR();
  vt_reads<2>(va, vtb);
  LGKM(2); SBAR(); if constexpr (NOMMA) asm volatile("" :: "v"(vb_.lo), "v"(vb_.hi_)); else if (do_pv) o[1] = __builtin_amdgcn_mfma_scale_f32_32x32x64_f8f6f4(pa8, CAT8A(vb_.lo, vb_.hi_), o[1], 0, 0, 0, 0, 0, 0); SBAR();
  vt_reads<3>(vb_, vtb);
  LGKM(2); SBAR(); if constexpr (NOMMA) asm volatile("" :: "v"(va.lo), "v"(va.hi_)); else if (do_pv) o[2] = __builtin_amdgcn_mfma_scale_f32_32x32x64_f8f6f4(pa8, CAT8A(va.lo, va.hi_), o[2], 0, 0, 0, 0, 0, 0); SBAR();
  LGKM(0); SBAR(); if constexpr (NOMMA) asm volatile("" :: "v"(vb_.lo), "v"(vb_.hi_)); else if (do_pv) o[3] = __builtin_amdgcn_mfma_scale_f32_32x32x64_f8f6f4(pa8, CAT8A(vb_.lo, vb_.hi_), o[3], 0, 0, 0, 0, 0, 0); SBAR();
}
template <bool NOMMA = false, bool NOWAIT = false> __device__ __forceinline__ void x8_a(f32x16& p0, f32x16& p1, KFrag8& ka, KFrag8& kb, const int (&k8b)[2][2], const int (&kr8b)[2], const v8i_a (&q8)[3], VFrag8& v0, const int (&vtb)[2]) {
  p0 = f32x16{}; p1 = f32x16{};
  k8_reads<0>(ka, k8b, kr8b); k8_reads<1>(kb, k8b, kr8b);
  if constexpr (!NOWAIT) LGKM(4); SBAR(); k8_mma<NOMMA>(p0, p1, ka, q8[0]); SBAR();
  k8_reads<2>(ka, k8b, kr8b); vt_reads<0>(v0, vtb);
}
template <bool NOMMA = false, bool NOWAIT = false> __device__ __forceinline__ void x8_b(f32x16& p0, f32x16& p1, const KFrag8& kb, const v8i_a (&q8)[3], VFrag8& v1, VFrag8& v2, const int (&vtb)[2]) {
  if constexpr (!NOWAIT) LGKM(6); SBAR(); k8_mma<NOMMA>(p0, p1, kb, q8[1]); SBAR();
  vt_reads<1>(v1, vtb); vt_reads<2>(v2, vtb);
}
template <bool NOMMA = false, bool NOPV = false, bool NOWAIT = false> __device__ __forceinline__ void x8_c(f32x16& p0, f32x16& p1, f32x16* o, const KFrag8& ka, const v8i_a (&q8)[3], const VFrag8& v0, const VFrag8& v1, const VFrag8& v2, VFrag8& v3, const int (&vtb)[2], bool do_pv, v8i_a pa8) {
  if constexpr (!NOWAIT) LGKM(6); SBAR(); k8_mma<NOMMA>(p0, p1, ka, q8[2]); SBAR();
  vt_reads<3>(v3, vtb);
#define PV8(I, V, CNT) if constexpr (!NOWAIT) LGKM(CNT); SBAR(); if constexpr (NOMMA || NOPV) asm volatile("" :: "v"(V.lo), "v"(V.hi_)); else if (do_pv) o[I] = __builtin_amdgcn_mfma_scale_f32_32x32x64_f8f6f4(pa8, CAT8A(V.lo, V.hi_), o[I], 0, 0, 0, 0, 0, 0); else asm volatile("" :: "v"(V.lo), "v"(V.hi_)); SBAR();
  PV8(0, v0, 6) PV8(1, v1, 4) PV8(2, v2, 2) PV8(3, v3, 0)
#undef PV8
}
__device__ __forceinline__ void pv8_tail(f32x16* o, const int (&vtb)[2], v8i_a pa8) {
  VFrag8 va, vb_;
  vt_reads<0>(va, vtb); vt_reads<1>(vb_, vtb);
  LGKM(2); SBAR(); o[0] = __builtin_amdgcn_mfma_scale_f32_32x32x64_f8f6f4(pa8, CAT8A(va.lo, va.hi_), o[0], 0, 0, 0, 0, 0, 0); SBAR();
  vt_reads<2>(va, vtb);
  LGKM(2); SBAR(); o[1] = __builtin_amdgcn_mfma_scale_f32_32x32x64_f8f6f4(pa8, CAT8A(vb_.lo, vb_.hi_), o[1], 0, 0, 0, 0, 0, 0); SBAR();
  vt_reads<3>(vb_, vtb);
  LGKM(2); SBAR(); o[2] = __builtin_amdgcn_mfma_scale_f32_32x32x64_f8f6f4(pa8, CAT8A(va.lo, va.hi_), o[2], 0, 0, 0, 0, 0, 0); SBAR();
  LGKM(0); SBAR(); o[3] = __builtin_amdgcn_mfma_scale_f32_32x32x64_f8f6f4(pa8, CAT8A(vb_.lo, vb_.hi_), o[3], 0, 0, 0, 0, 0, 0); SBAR();
}
template <bool NOEXP = false> __device__ __forceinline__ void finishSM8(f32x16& p0, f32x16& p1, float alpha, float& l_reg, v8i_a& pa8) {
#pragma unroll
  for (int r = 0; r < 16; ++r) p1[r] = NOEXP ? p1[r] : __builtin_amdgcn_exp2f(p1[r]);
  float ps = 0;
#pragma unroll
  for (int r = 0; r < 16; ++r) ps += p0[r];
#pragma unroll
  for (int r = 0; r < 16; ++r) ps += p1[r];
  { auto rr = __builtin_amdgcn_permlane32_swap(__float_as_uint(ps), __float_as_uint(ps), false, false);
    ps = __uint_as_float(rr[0]) + __uint_as_float(rr[1]); }
  l_reg = l_reg * alpha + ps;
#pragma unroll
  for (int g = 0; g < 4; ++g) {
    int d0 = __builtin_amdgcn_cvt_pk_fp8_f32(p0[4 * g], p0[4 * g + 1], 0, false); d0 = __builtin_amdgcn_cvt_pk_fp8_f32(p0[4 * g + 2], p0[4 * g + 3], d0, true);
    int d1 = __builtin_amdgcn_cvt_pk_fp8_f32(p1[4 * g], p1[4 * g + 1], 0, false); d1 = __builtin_amdgcn_cvt_pk_fp8_f32(p1[4 * g + 2], p1[4 * g + 3], d1, true);
    auto sw = __builtin_amdgcn_permlane32_swap((unsigned)d0, (unsigned)d1, false, false);
    pa8[2 * g] = (int)sw[0]; pa8[2 * g + 1] = (int)sw[1]; }
}
#undef CAT8A
#undef LGKM

struct UnitArgs {
  const bf16* Q;
  const bf16* K; const bf16* V;
  const bf16* KR;
  unsigned char* O;
  int NT, seg0_tiles, seg0_row, seg1_row;
  float C;
  const float* rpb;
  int lo_row, r0;
};

template <int MODE, int VAR = 0>
__device__ __forceinline__ void attn_unit(const UnitArgs& A, __attribute__((address_space(3))) unsigned char* ldsl, const int wid0) {
  typedef __attribute__((address_space(3))) unsigned LU;
  constexpr bool F8 = (MODE == 2);
  constexpr int ND0 = 8, LDQ = F8 ? 3072 : 1024, LDK = F8 ? 2048 : 1024, LDO = 2048;
  char* lds = (char*)ldsl;
  int wid_ = wid0; asm volatile("" : "+s"(wid_));
  const int wid = wid_, lane = hw_lane(), tid = wid * 64 + lane, r32 = lane & 31, hi = lane >> 5;
  char* V_lds = lds + OFF_V; char* K_lds = lds + OFF_K; char* KR_lds = lds + OFF_KR;
  float* wsf = (float*)(lds + OFF_WS) + wid * 64; float* li_l = wsf; float* al_l = wsf + 32;
  float* rpbL = (float*)(lds + OFF_RPB);
  float m_reg = -1e30f, l_reg = 0; f32x16 o[4] = {}; bf16x8 qr[ND0];
  v8i_a q8[3];
  if constexpr (F8) { const unsigned char* Qb = (const unsigned char*)A.Q + (long)(wid * QBLK + r32) * LDQ + hi * 32;
#pragma unroll
    for (int kbk = 0; kbk < 3; ++kbk) q8[kbk] = *reinterpret_cast<const v8i_a*>(Qb + kbk * 64); }
  else { const bf16* Qw = A.Q + (long)(wid * QBLK + r32) * LDQ + hi * 8;
#pragma unroll
    for (int d0 = 0; d0 < ND0; ++d0) qr[d0] = *reinterpret_cast<const bf16x8*>(Qw + d0 * 16); }
  if constexpr (MODE == 1) { if (A.rpb && tid < 465) rpbL[tid] = A.rpb[tid] * 1.4426950408889634f; }
  int koff[2], voff[2], kroff = 0;
#pragma unroll
  for (int i = 0; i < 2; ++i) { const int ob = (wid * 2 + i) * 1024 + lane * 16;
    { const int row = ob >> 8, w = ob & 255, cb = w ^ ((row & 15) << 4); koff[i] = row * LDK + (cb >> 1); }
    { const int sub = ob >> 9, within = ob & 511, kk = (sub >> 2) * 8 + (within >> 6), k = (kk & ~0xC) | ((kk & 4) << 1) | ((kk & 8) >> 1), col = (sub & 3) * 32 + ((within & 63) >> 1); voff[i] = k * LDK + col; } }
  int vtoff = 0;
  if constexpr (F8) { const int ob = wid * 1024 + lane * 16, d = ob >> 6, ch = ((ob & 63) >> 4) ^ ((d >> 2) & 3); vtoff = d * VT_PITCH + ch * 16; }
  int k8off = 0;
  if constexpr (F8) { { const int ob = wid * 1024 + lane * 16, row = ob >> 7, ch = ((ob & 127) >> 4) ^ ((row >> 1) & 7); k8off = row * LDK + ch * 16; }
    { const int ob = (wid & 3) * 1024 + lane * 16, row = ob >> 6, ch = ((ob & 63) >> 4) ^ ((row >> 2) & 3); kroff = row * 64 + ch * 16; } }
  const int vb0 = (int)(uintptr_t)V_lds + v_rd_base(lane);
  int vtb0[2];
#pragma unroll
  for (int jj = 0; jj < 2; ++jj) vtb0[jj] = (int)(uintptr_t)V_lds + r32 * 64 + (((2 * hi + jj) ^ ((r32 >> 2) & 3)) << 4);
  int k8b0[2][2], kr8b0[2];
#pragma unroll
  for (int kbk = 0; kbk < 2; ++kbk)
#pragma unroll
    for (int jj = 0; jj < 2; ++jj) k8b0[kbk][jj] = (int)(uintptr_t)K_lds + r32 * 128 + (((4 * kbk + 2 * hi + jj) ^ ((r32 >> 1) & 7)) << 4);
#pragma unroll
  for (int jj = 0; jj < 2; ++jj) kr8b0[jj] = (int)(uintptr_t)KR_lds + r32 * 64 + (((2 * hi + jj) ^ ((r32 >> 2) & 3)) << 4);
  int kb[8], krb[4];
#pragma unroll
  for (int x = 0; x < 8; ++x) kb[x] = (int)(uintptr_t)K_lds + r32 * 256 + ((x * 32 + hi * 16) ^ ((r32 & 15) << 4));
#pragma unroll
  for (int x = 0; x < 4; ++x) krb[x] = (int)(uintptr_t)KR_lds + r32 * 128 + (((x * 2 + hi) ^ ((r32 >> 1) & 7)) << 4);
  const float C = A.C;
  int qc = 0, cs = 0, qrow = 0, rs = 0;
  if constexpr (MODE == 1) { qc = (wid & 1) * 32 + r32; cs = qc - 8; cs = cs < 0 ? 0 : (cs > 48 ? 48 : cs); qrow = A.r0 + (wid >> 1); rs = qrow - 4; rs = rs < 0 ? 0 : (rs > 56 ? 56 : rs); }
#define TROW(j) ((j) < A.seg0_tiles ? A.seg0_row + 64 * (j) : A.seg1_row + 64 * ((j) - A.seg0_tiles))
#define DMA16(gp, ldsoff) __builtin_amdgcn_global_load_lds((const unsigned*)(gp), (LU*)(ldsl + (ldsoff)), 16, 0, 0)
#define ISSUE_K(j, slot) do { const long R0_ = TROW(j); if constexpr (F8) { DMA16((const unsigned char*)A.K + R0_ * LDK + k8off, OFF_K + (slot) * SHM_K + wid * 1024); \
      if (wid < 4) DMA16((const unsigned char*)A.KR + R0_ * 64 + kroff, OFF_KR + (slot) * SHM_KR + wid * 1024); } else { const bf16* kb_ = A.K + R0_ * LDK; \
    DMA16(kb_ + koff[0], OFF_K + (slot) * SHM_K + (wid * 2) * 1024); DMA16(kb_ + koff[1], OFF_K + (slot) * SHM_K + (wid * 2 + 1) * 1024); } } while (0)
#define ISSUE_K2(j, slot) do { const long R0_ = TROW(j); if constexpr (F8) { const unsigned char* k8_ = (const unsigned char*)A.K + R0_ * LDK + k8off; \
      DMA16(k8_, OFF_K + (slot) * SHM_K + wid * 1024); DMA16(k8_ + 32 * LDK, OFF_K + (slot) * SHM_K + (wid + 4) * 1024); \
      DMA16((const unsigned char*)A.KR + R0_ * 64 + kroff, OFF_KR + (slot) * SHM_KR + wid * 1024); } else { const bf16* kb_ = A.K + R0_ * LDK; const bf16* kb2_ = kb_ + 32 * LDK; \
    DMA16(kb_ + koff[0], OFF_K + (slot) * SHM_K + (wid * 2) * 1024); DMA16(kb_ + koff[1], OFF_K + (slot) * SHM_K + (wid * 2 + 1) * 1024); \
    DMA16(kb2_ + koff[0], OFF_K + (slot) * SHM_K + (wid * 2 + 8) * 1024); DMA16(kb2_ + koff[1], OFF_K + (slot) * SHM_K + (wid * 2 + 9) * 1024); } } while (0)
#define ISSUE_V(j, slot) do { const long R0_ = TROW(j); if constexpr (F8) { DMA16((const unsigned char*)A.V + R0_ + vtoff, OFF_V + (slot) * SHM_V + wid * 1024); } else { const bf16* vb_ = A.V + R0_ * LDK; \
    DMA16(vb_ + voff[0], OFF_V + (slot) * SHM_V + (wid * 2) * 1024); DMA16(vb_ + voff[1], OFF_V + (slot) * SHM_V + (wid * 2 + 1) * 1024); } } while (0)
#define ISSUE_V2(j, slot) do { const long R0_ = TROW(j); if constexpr (F8) { const unsigned char* vt_ = (const unsigned char*)A.V + R0_ + vtoff; \
      DMA16(vt_, OFF_V + (slot) * SHM_V + wid * 1024); DMA16(vt_ + 64 * (long)VT_PITCH, OFF_V + (slot) * SHM_V + (wid + 4) * 1024); } else { const bf16* vb_ = A.V + R0_ * LDK; const bf16* vb2_ = vb_ + 32 * LDK; \
    DMA16(vb_ + voff[0], OFF_V + (slot) * SHM_V + (wid * 2) * 1024); DMA16(vb_ + voff[1], OFF_V + (slot) * SHM_V + (wid * 2 + 1) * 1024); \
    DMA16(vb2_ + voff[0], OFF_V + (slot) * SHM_V + (wid * 2 + 8) * 1024); DMA16(vb2_ + voff[1], OFF_V + (slot) * SHM_V + (wid * 2 + 9) * 1024); } } while (0)
#define RESC(a) do { if (__any((a) < 1.f)) { if (hi == 0) al_l[r32] = (a); asm volatile("s_waitcnt lgkmcnt(0)" ::: "memory"); \
    _Pragma("unroll") for (int d = 0; d < 4; ++d) _Pragma("unroll") for (int r = 0; r < 16; ++r) o[d][r] *= al_l[crow(r, hi)]; } } while (0)
#define BM_HALF(P, OFS) do { _Pragma("unroll") for (int g_ = 0; g_ < 4; ++g_) { _Pragma("unroll") for (int rr_ = 0; rr_ < 4; ++rr_) { const int r = 4 * g_ + rr_, k0_ = 8 * g_ + rr_ + (OFS); \
      P[r] = ((unsigned)(k0_ + kd_) < 16u) ? fmaf(P[r], C, bp_[k0_]) : -1e30f; } asm volatile("" ::: "memory"); } } while (0)
#define BIASMASK(P0, P1, j) do { if constexpr (MODE == 1) { \
    if ((j) < 4) { _Pragma("unroll") for (int r = 0; r < 16; ++r) { P0[r] *= C; P1[r] *= C; } } \
    else { const int kr_ = A.lo_row + (j) - 4, dr_ = kr_ - qrow; const bool rowok_ = (unsigned)(kr_ - rs) < 8u; \
      if (!rowok_) { _Pragma("unroll") for (int r = 0; r < 16; ++r) { P0[r] = -1e30f; P1[r] = -1e30f; } } \
      else { const float* bp_ = rpbL + (dr_ + 7) * 31 + 15 - qc + 4 * hi; const int kd_ = 4 * hi - cs; BM_HALF(P0, 0); BM_HALF(P1, 32); } } } } while (0)
  constexpr bool PRE = (MODE == 1);
  const bool grpB = wid >= 4;
  f32x16 p0, p1; float mn = 0.f, al = 1.f; bf16x8 pa0, pa1, pa2, pa3; const int NT = A.NT;
  pa0 = pa1 = pa2 = pa3 = bf16x8{}; v8i_a pa8 = {};
#define WAITG(nk_exists, nv_exists) do { if (nk_exists) { if constexpr (F8) asm volatile("s_waitcnt vmcnt(5) lgkmcnt(0)" ::: "memory"); else asm volatile("s_waitcnt vmcnt(8) lgkmcnt(0)" ::: "memory"); } \
    else if (nv_exists) { if constexpr (F8) asm volatile("s_waitcnt vmcnt(2) lgkmcnt(0)" ::: "memory"); else asm volatile("s_waitcnt vmcnt(4) lgkmcnt(0)" ::: "memory"); } else asm volatile("s_waitcnt vmcnt(0) lgkmcnt(0)" ::: "memory"); \
    __builtin_amdgcn_s_barrier(); asm volatile("" ::: "memory"); } while (0)
  ISSUE_K(0, 0); ISSUE_V(0, 0); ISSUE_K(1, 1);
  asm volatile("s_waitcnt vmcnt(0) lgkmcnt(0)" ::: "memory");
  if constexpr (F8) { asm volatile("" : "+v"(q8[0]), "+v"(q8[1]), "+v"(q8[2])); } else {
#pragma unroll
  for (int d0 = 0; d0 < ND0; ++d0) asm volatile("" : "+v"(qr[d0])); }
  __builtin_amdgcn_s_barrier(); asm volatile("" ::: "memory");
  if (grpB) { __builtin_amdgcn_s_barrier(); asm volatile("" ::: "memory"); }
  KFrag8 ka8, kb8;
  int sk = 0;
  for (int j = 0; j < NT; ++j) {
    const int s1_ = sk == 2 ? 0 : sk + 1, s2_ = sk == 0 ? 2 : sk - 1;
    if constexpr (F8) {
      if (grpB) { if (j + 1 < NT) asm volatile("s_waitcnt vmcnt(2)" ::: "memory"); else asm volatile("s_waitcnt vmcnt(1)" ::: "memory"); }
      __builtin_amdgcn_s_barrier(); asm volatile("" ::: "memory"); }
    else WAITG(j + 1 < NT, true);
    if constexpr (!F8) { if (!grpB) { if (j + 2 < NT) ISSUE_K2(j + 2, s2_); if (j + 1 < NT) ISSUE_V2(j + 1, s1_); } }
    if constexpr (F8) { const int kr8b[2] = {kr8b0[0] + sk * SHM_KR, kr8b0[1] + sk * SHM_KR};
      const int k8b[2][2] = {{k8b0[0][0] + sk * SHM_K, k8b0[0][1] + sk * SHM_K}, {k8b0[1][0] + sk * SHM_K, k8b0[1][1] + sk * SHM_K}};
      const int vtb[2] = {vtb0[0] + s2_ * SHM_V, vtb0[1] + s2_ * SHM_V};
      VFrag8 v0, v1, v2, v3;
      SBAR(); __builtin_amdgcn_s_setprio(1);
      if constexpr (VAR != 8) x8_a<VAR == 2 || VAR == 5 || VAR == 7, VAR == 9>(p0, p1, ka8, kb8, k8b, kr8b, q8, v0, vtb);
      SBAR(); if (VAR != 7) { if (j + 2 < NT) ISSUE_K(j + 2, s2_); } SBAR();
      if constexpr (VAR != 8) x8_b<VAR == 2 || VAR == 5 || VAR == 7, VAR == 9>(p0, p1, kb8, q8, v1, v2, vtb);
      SBAR(); if (VAR != 7) { if (j + 1 < NT) ISSUE_V(j + 1, s1_); } SBAR();
      if constexpr (VAR != 8) x8_c<VAR == 2 || VAR == 5 || VAR == 7, VAR == 6, VAR == 9>(p0, p1, o, ka8, q8, v0, v1, v2, v3, vtb, j > 0, pa8);
      __builtin_amdgcn_s_setprio(0); }
    else { int kbs[8], krbs[4];
#pragma unroll
      for (int x = 0; x < 8; ++x) kbs[x] = kb[x] + sk * SHM_K;
#pragma unroll
      for (int x = 0; x < 4; ++x) krbs[x] = krb[x] + sk * SHM_KR;
      SBAR(); __builtin_amdgcn_s_setprio(1); x_phase<ND0>(p0, p1, o, kbs, krbs, qr, vb0 + s2_ * SHM_V, j > 0, pa0, pa1, pa2, pa3); __builtin_amdgcn_s_setprio(0); }
    SBAR();
    if constexpr (F8) {
      if (grpB) asm volatile("s_waitcnt lgkmcnt(0)" ::: "memory"); else if (j + 1 >= NT) asm volatile("s_waitcnt vmcnt(0) lgkmcnt(0)" ::: "memory"); else if (j + 2 < NT) asm volatile("s_waitcnt vmcnt(3) lgkmcnt(0)" ::: "memory"); else asm volatile("s_waitcnt vmcnt(1) lgkmcnt(0)" ::: "memory");
      __builtin_amdgcn_s_barrier(); asm volatile("" ::: "memory"); }
    else WAITG(j + 2 < NT, j + 1 < NT);
    if constexpr (VAR != 3 && VAR < 5) { BIASMASK(p0, p1, j); partialSM<PRE, F8, VAR == 1>(p0, p1, m_reg, mn, al, C); RESC(al);
    if constexpr (F8) finishSM8<VAR == 1>(p0, p1, al, l_reg, pa8); else finishSM(p0, p1, al, l_reg, pa0, pa1, pa2, pa3); }
    else { asm volatile("" : "+v"(p0), "+v"(p1)); }
    sk = s1_;
  }
  asm volatile("s_waitcnt vmcnt(0) lgkmcnt(0)" ::: "memory"); __builtin_amdgcn_s_barrier(); asm volatile("" ::: "memory");
  { const int s2_ = sk == 0 ? 2 : sk - 1; SBAR(); if constexpr (F8) { const int vtb[2] = {vtb0[0] + s2_ * SHM_V, vtb0[1] + s2_ * SHM_V}; pv8_tail(o, vtb, pa8); } else pv_d0(o, vb0 + s2_ * SHM_V, pa0, pa1, pa2, pa3); }
  if (!grpB) { __builtin_amdgcn_s_barrier(); asm volatile("" ::: "memory"); }
#undef WAITG
  if (hi == 0) li_l[r32] = l_reg; asm volatile("s_waitcnt lgkmcnt(0)" ::: "memory");
  unsigned char* Ow = A.O + (long)(wid * QBLK) * LDO;
  const bool pb = (lane & 1) != 0, sb = (lane & 2) != 0;
#pragma unroll
  for (int g = 0; g < 4; ++g) {
    float inv[4];
#pragma unroll
    for (int i = 0; i < 4; ++i) inv[i] = __builtin_amdgcn_rcpf(li_l[crow(4 * g + i, hi)]) * O_SCALE;
#pragma unroll
    for (int d0 = 0; d0 < 4; ++d0) {
      const float a0 = o[d0][4 * g] * inv[0], a1 = o[d0][4 * g + 1] * inv[1], a2 = o[d0][4 * g + 2] * inv[2], a3 = o[d0][4 * g + 3] * inv[3];
      const float r0 = shfl_xor_c<1>(pb ? a0 : a1), r1 = shfl_xor_c<1>(pb ? a2 : a3);
      const float c00 = pb ? r0 : a0, c01 = pb ? a1 : r0, c10 = pb ? r1 : a2, c11 = pb ? a3 : r1;
      const float t0 = shfl_xor_c<2>(sb ? c00 : c10), t1 = shfl_xor_c<2>(sb ? c01 : c11);
      const float m0 = sb ? c10 : c00, m1 = sb ? c11 : c01;
      const float b0 = sb ? t0 : m0, b1 = sb ? t1 : m1, b2 = sb ? m0 : t0, b3 = sb ? m1 : t1;
      *reinterpret_cast<unsigned*>(Ow + (long)((lane & 3) + 8 * g + 4 * hi) * LDO + d0 * 32 + (r32 & ~3)) = pg8::pk4_fp8(b0, b1, b2, b3); } }
  asm volatile("s_waitcnt vmcnt(0) lgkmcnt(0)" ::: "memory"); __builtin_amdgcn_s_barrier(); asm volatile("" ::: "memory");
#undef TROW
#undef DMA16
#undef ISSUE_K
#undef ISSUE_V
#undef ISSUE_K2
#undef ISSUE_V2
#undef RESC
#undef BIASMASK
#undef BM_HALF
}
#undef KSWZ
#undef KRSWZ
#undef SBAR
}

constexpr int NWAVES = 8;
constexpr int DM = 2048, DFF = 5632, MCTX = 4096, MLAT = 32768, MTOK = MCTX + MLAT  , MCACHE = 2048, MKV = MTOK + MCACHE  ;
constexpr int NCOND = 9, NMODC = 9 * DM  ;
constexpr float ALPHA = 1.4142135623730951f, LN_EPS = 1e-5f, RMS_EPS = 1e-6f;
constexpr int NDOWN = 1280;
enum { I_XP = 0, I_XS, I_CNK, I_CNV, I_CCKV, I_CKPE, I_C, I_CCTX, I_WMOD, I_BMOD, I_LNG, I_LNB, I_W1, I_W3, I_W2, I_WIN, I_WMIXO, I_RPB, I_POOLW, I_POOLS, I_WDOWN, I_QNORM, I_WUQ, I_KVNORM, I_WUKV, I_WOUT, N_IN };
constexpr size_t OUT_Y = 0, OUT_NAK = (size_t)MTOK * DM, OUT_NAV = OUT_NAK + (size_t)MCTX * 1024, OUT_CKV = OUT_NAV + (size_t)MCTX * 1024, OUT_KPE = OUT_CKV + (size_t)MCTX * 512, OUT_END = OUT_KPE + (size_t)MCTX * 64;
constexpr size_t MiB = 1u << 20;
constexpr size_t al256(size_t x) { return (x + 255) / 256 * 256; }
constexpr size_t WS_CTL = 0, CTL_ZERO_BYTES = 1 * MiB;
constexpr size_t WS_MOD = 1 * MiB;
constexpr size_t WS_ROPE = WS_MOD + al256((size_t)NCOND * 2 * NMODC * 4);
constexpr size_t WS_ST = WS_ROPE + 8192;
constexpr size_t WS_IDLN = WS_ST + al256((size_t)MTOK * 8);
constexpr size_t WS_AB = WS_IDLN + 16384;
constexpr size_t WS_W13 = WS_AB + al256((size_t)NCOND * 6 * 2 * DM * 4);
constexpr size_t SZ_W13 = (size_t)2 * DFF * DM, SZ_W2 = (size_t)DM * DFF;
constexpr size_t WS_W2 = WS_W13 + 4 * SZ_W13;
constexpr size_t WS_WIN = WS_W2 + 4 * SZ_W2;
constexpr size_t WS_WMIX = WS_WIN + (size_t)4096 * DM * 2;
constexpr size_t WS_WDOWN = WS_WMIX + (size_t)DM * DM * 2;
constexpr size_t WS_WUQ = WS_WDOWN + (size_t)NDOWN * DM * 2;
constexpr size_t WS_WUKV = WS_WUQ + (size_t)3072 * 512 * 2;
constexpr size_t WS_WOUT = WS_WUKV + (size_t)4096 * 512 * 2;
constexpr size_t WS_WIN8 = WS_WOUT + (size_t)DM * DM * 2;
constexpr size_t WS_WDOWN8 = WS_WIN8 + (size_t)4096 * DM;
constexpr size_t WS_H = WS_WDOWN8 + (size_t)NDOWN * DM;
constexpr size_t WS_T = WS_H + (size_t)MTOK * DM * 2;
constexpr size_t WS_S = WS_T + (size_t)MTOK * DM * 2;
constexpr size_t WS_G = WS_S;
constexpr size_t SZ_QKVU = (size_t)MKV * 1024 * 2;
constexpr size_t WS_EQ = WS_S, WS_CAT = WS_S + 4 * SZ_QKVU;
constexpr size_t WS_DOWN = WS_S, WS_MQ = WS_S;
constexpr size_t WS_CQ = WS_S + (size_t)MTOK * 3072 * 2;
constexpr size_t WS_CKV = WS_CQ + (size_t)MTOK * 512 * 2;
constexpr size_t WS_KPE = WS_CKV + (size_t)MKV * 512 * 2;
constexpr size_t WS_KV = WS_KPE + (size_t)MKV * 64 * 2;
constexpr size_t WS_END_ODD = WS_KV + (size_t)MKV * 4096 * 2, WS_END_EVEN = WS_CAT + (size_t)MTOK * DM * 2, WS_END_FFN = WS_G + (size_t)MTOK * DFF;
constexpr size_t WS_END = WS_END_ODD > WS_END_EVEN ? (WS_END_ODD > WS_END_FFN ? WS_END_ODD : WS_END_FFN) : (WS_END_EVEN > WS_END_FFN ? WS_END_EVEN : WS_END_FFN);
static_assert((size_t)MTOK * NDOWN * 4 <= (size_t)MTOK * 3072 * 2, "DOWN fits under Q");
constexpr int CW_BAR = 4096;
constexpr int MAX_LAUNCH = 32;
static_assert((CW_BAR + MAX_LAUNCH * 3456) * 4 <= (int)CTL_ZERO_BYTES, "CTL");
constexpr int RING_OFF = 0, RING_BYTES = 131072, LDSCTL_OFF = RING_BYTES, MISC_OFF = LDSCTL_OFF + 320, LDS_BYTES = 147456;

#define GAS __attribute__((address_space(1)))
#define LAS __attribute__((address_space(3)))
typedef unsigned short bf16;
typedef unsigned v4u __attribute__((ext_vector_type(4)));
typedef unsigned v2u __attribute__((ext_vector_type(2)));
typedef float f32x4 __attribute__((ext_vector_type(4)));
#define LDS_WAIT() asm volatile("s_waitcnt lgkmcnt(0)" ::: "memory")
#define VM_WAIT() asm volatile("s_waitcnt vmcnt(0)" ::: "memory")
__device__ __forceinline__ unsigned f2bf(float f) { unsigned u = __builtin_bit_cast(unsigned, f); return (u + 0x7fffu + ((u >> 16) & 1u)) >> 16; }
__device__ __forceinline__ unsigned pk2(float lo, float hi) { return f2bf(lo) | (f2bf(hi) << 16); }
__device__ __forceinline__ float bf2f(unsigned short b) { return __builtin_bit_cast(float, (unsigned)b << 16); }
#define XB_TMO      128
#define XB_XCNT(j)  (256  + 64 * (j))
#define XB_XSUB(j)  (1280 + 64 * (j))
#define XB_XGEN(j)  (2304 + 64 * (j))
#define XB_TOP      3328
#define XB_TOPGEN   3392
#define XCD_BAR_WORDS 3456
#define XB_SPIN_CAP (1u << 18)

__device__ __forceinline__ unsigned xb_ld(unsigned* p)              { return __hip_atomic_load(p, __ATOMIC_RELAXED, __HIP_MEMORY_SCOPE_AGENT); }
__device__ __forceinline__ unsigned xb_add(unsigned* p, unsigned v) { return __hip_atomic_fetch_add(p, v, __ATOMIC_RELAXED, __HIP_MEMORY_SCOPE_AGENT); }
__device__ __forceinline__ unsigned xb_xcc_id() { return (unsigned)__builtin_amdgcn_s_getreg((3 << 11) | 20) & 0xFu; }
#define XB_SPIN(cond, bar) do { unsigned _sp = 0; while (cond) { __builtin_amdgcn_s_sleep(1); \
    if ((++_sp & 255u) == 0u) { if (xb_ld(&(bar)[XB_TMO])) break; if (_sp > XB_SPIN_CAP) { atomicAdd(&(bar)[XB_TMO], 1u); break; } } } } while (0)

struct XcdBarrier {
    unsigned* bar; unsigned x; int wid0;
    volatile LAS unsigned* st;
};

__device__ __forceinline__ XcdBarrier xcd_barrier_post(unsigned* bar, volatile LAS unsigned* st, int wid0) {
    XcdBarrier b; b.bar = bar; b.x = xb_xcc_id(); b.st = st; b.wid0 = wid0;
    if (wid0 == 0 && hw_lane() == 0) (void)xb_add(&bar[XB_XCNT(b.x)], 1u);
    return b;
}
__device__ __forceinline__ void xcd_barrier_complete(unsigned* bar, unsigned x, unsigned& nloc, unsigned& nx) {
    const unsigned G = gridDim.x * gridDim.y * gridDim.z;
    unsigned sum, cnt, mine, sp = 0u;
    for (;;) {
        sum = 0u; cnt = 0u; mine = 0u;
#pragma unroll
        for (unsigned j = 0; j < 16; ++j) { const unsigned c = xb_ld(&bar[XB_XCNT(j)]); sum += c; cnt += (c > 0u) ? 1u : 0u; mine = (j == x) ? c : mine; }
        if (sum == G) break;
        __builtin_amdgcn_s_sleep(1);
        if ((++sp & 255u) == 0u) { if (xb_ld(&bar[XB_TMO])) break; if (sp > XB_SPIN_CAP) { atomicAdd(&bar[XB_TMO], 1u); break; } }
    }
    nloc = mine > 0u ? mine : 1u; nx = cnt > 0u ? cnt : 1u;
}

__device__ __forceinline__ void xcd_barrier(const XcdBarrier& b) {
    asm volatile("s_waitcnt vmcnt(0)" ::: "memory");
    __syncthreads();
    if (b.wid0 == 0 && hw_lane() == 0) {
        unsigned* bar = b.bar;
        __builtin_amdgcn_s_waitcnt(0);
        unsigned nloc = b.st[0], nx = b.st[1];
        if (nloc == 0u) { xcd_barrier_complete(bar, b.x, nloc, nx); b.st[0] = nloc; b.st[1] = nx; }
        const unsigned old = xb_add(&bar[XB_XSUB(b.x)], 1u);
        const unsigned gen = old / nloc;
        if (old + 1u == (gen + 1u) * nloc) {
            __builtin_amdgcn_fence(__ATOMIC_RELEASE, "agent");
            asm volatile("s_waitcnt vmcnt(0)" ::: "memory");
            const unsigned og = xb_add(&bar[XB_TOP], 1u);
            const unsigned tg = og / nx;
            if (og + 1u == (tg + 1u) * nx) xb_add(&bar[XB_TOPGEN], 1u);
            else XB_SPIN(xb_ld(&bar[XB_TOPGEN]) == tg, bar);
            __builtin_amdgcn_fence(__ATOMIC_ACQUIRE, "agent");
            xb_add(&bar[XB_XGEN(b.x)], 1u);
            asm volatile("s_waitcnt vmcnt(0)" ::: "memory");
        } else {
            XB_SPIN(xb_ld(&bar[XB_XGEN(b.x)]) == gen, bar);
            __builtin_amdgcn_fence(__ATOMIC_ACQUIRE, "agent");
            asm volatile("s_waitcnt vmcnt(0)" ::: "memory");
        }
    }
    __syncthreads();
}
struct Args { const float* in[N_IN]; float* out; unsigned char* ws; int ph_lo, ph_hi, li, pad; };
#define CAS __attribute__((address_space(4)))
typedef const float* CFP;
typedef CAS const CFP* KargTab;
struct Frame {
    LAS unsigned char* lds; volatile LAS unsigned* MISC; unsigned* ctl;
    int tid, lane, wave, vcu, G, gw, NGW, wid0, probe;
    KargTab in; float* out; unsigned char* ws;
};
__device__ __forceinline__ float wave_sum(float v) {
    v += shfl_xor_c<1>(v); v += shfl_xor_c<2>(v); v += shfl_xor_c<4>(v); v += shfl_xor_c<8>(v); v += shfl_xor_c<16>(v);
    const int x = __builtin_bit_cast(int, v);
    return __builtin_bit_cast(float, __builtin_amdgcn_readlane(x, 0)) + __builtin_bit_cast(float, __builtin_amdgcn_readlane(x, 32));
}
__device__ __forceinline__ int cond_of_row(int r) { return r < MCTX ? 0 : 1 + ((r - MCTX) >> 12); }
__device__ __forceinline__ int rope_pos(int e) { const int w = e & 31; return (e & 32) + 8 * ((w & 15) >> 2) + 4 * (w >> 4) + (w & 3); }
__device__ __forceinline__ int rope_orig(int p) { const int q = p & 31; return (p & 32) + 16 * ((q >> 2) & 1) + 4 * (q >> 3) + (q & 3); }
enum { MAP_ID = 0, MAP_W1, MAP_W3, MAP_UQ, MAP_DOWN };
__device__ __forceinline__ int map_row(int mode, int off, int n) {
    if (mode == MAP_W1) return 256 * (n >> 7) + (n & 127);
    if (mode == MAP_W3) return 256 * (n >> 7) + 128 + (n & 127);
    if (mode == MAP_UQ) { const int h = n / 192, d = n - h * 192; return d < 128 ? n : h * 192 + 128 + rope_pos(d - 128); }
    if (mode == MAP_DOWN) return n < 1024 ? n : 1024 + rope_pos(n - 1024);
    return off + n;
}
__device__ __forceinline__ void tr_matrix(Frame& F, const float* W, int K, int N, int ldn, bf16* WT, int ldw, int mode, int off) {
    LAS float* scr = (LAS float*)(F.lds + RING_OFF + F.wave * 16384);
    const int nblk = N / 32, nitems = (K / 64) * nblk, lane = F.lane;
    for (int item = F.gw; item < nitems; item += F.NGW) {
        const int kb = item / nblk, nb = item - kb * nblk, k0 = 64 * kb, n0 = 32 * nb;
#pragma unroll 8
        for (int i = 0; i < 32; ++i) { const int kk = 2 * i + (lane >> 5); scr[kk * 33 + (lane & 31)] = W[(size_t)(k0 + kk) * ldn + n0 + (lane & 31)]; }
        LDS_WAIT(); asm volatile("" ::: "memory");
        const int c = lane & 7;
#pragma unroll
        for (int j = 0; j < 4; ++j) { const int n = (lane >> 3) + 8 * j; const LAS float* s = scr + (8 * c) * 33 + n;
            v4u o; o.x = pk2(s[0 * 33], s[1 * 33]); o.y = pk2(s[2 * 33], s[3 * 33]); o.z = pk2(s[4 * 33], s[5 * 33]); o.w = pk2(s[6 * 33], s[7 * 33]);
            *(GAS v4u*)(WT + (size_t)map_row(mode, off, n0 + n) * ldw + k0 + 8 * c) = o; }
        LDS_WAIT(); asm volatile("" ::: "memory");
    }
}
__device__ __forceinline__ void tr_matrix8(Frame& F, const float* W, int K, int N, int ldn, unsigned char* WT, int ldw, int mode, float scale) {
    LAS float* scr = (LAS float*)(F.lds + RING_OFF + F.wave * 16384);
    const int nblk = N / 32, nitems = (K / 64) * nblk, lane = F.lane;
    for (int item = F.gw; item < nitems; item += F.NGW) {
        const int kb = item / nblk, nb = item - kb * nblk, k0 = 64 * kb, n0 = 32 * nb;
#pragma unroll 8
        for (int i = 0; i < 32; ++i) { const int kk = 2 * i + (lane >> 5); scr[kk * 33 + (lane & 31)] = W[(size_t)(k0 + kk) * ldn + n0 + (lane & 31)] * scale; }
        LDS_WAIT(); asm volatile("" ::: "memory");
        const int c = lane & 3;
#pragma unroll
        for (int j = 0; j < 2; ++j) { const int n = (lane >> 2) + 16 * j; const LAS float* s = scr + (16 * c) * 33 + n;
            v4u o; o.x = pg8::pk4_fp8(s[0 * 33], s[1 * 33], s[2 * 33], s[3 * 33]); o.y = pg8::pk4_fp8(s[4 * 33], s[5 * 33], s[6 * 33], s[7 * 33]);
            o.z = pg8::pk4_fp8(s[8 * 33], s[9 * 33], s[10 * 33], s[11 * 33]); o.w = pg8::pk4_fp8(s[12 * 33], s[13 * 33], s[14 * 33], s[15 * 33]);
            *(GAS v4u*)(WT + (size_t)map_row(mode, 0, n0 + n) * ldw + k0 + 16 * c) = o; }
        LDS_WAIT(); asm volatile("" ::: "memory");
    }
}
__device__ __forceinline__ void p0_prologue(Frame& F) {
    KargTab in = F.in; unsigned char* ws = F.ws;
    if ((int)blockIdx.x < 2 * NMODC / 256) {
        LAS float* sl = (LAS float*)(F.lds + RING_OFF);
        for (int i = F.tid; i < NCOND * DM; i += NWAVES * 64) { const int ci = i / DM, k = i - ci * DM; const float c = ci == 0 ? in[I_CCTX][k] : in[I_C][(ci - 1) * DM + k];
            sl[k * 12 + ci] = c / (1.0f + __expf(-c)); }
        __syncthreads();
        const int col0 = (int)blockIdx.x * 256, l = col0 / NMODC, jj0 = col0 - l * NMODC;
        const float* wp = in[I_WMOD] + ((size_t)l * DM + F.wave * 256) * NMODC + jj0 + F.lane * 4;
        f32x4 acc[NCOND];
#pragma unroll
        for (int ci = 0; ci < NCOND; ++ci) acc[ci] = (f32x4){0.f, 0.f, 0.f, 0.f};
#pragma unroll 4
        for (int k = 0; k < 256; ++k) { const f32x4 w = *(const GAS f32x4*)(wp + (size_t)k * NMODC); const LAS f32x4* sp = (const LAS f32x4*)(sl + (F.wave * 256 + k) * 12);
            const f32x4 s0 = sp[0], s1 = sp[1], s2 = sp[2];
            acc[0] += w * s0[0]; acc[1] += w * s0[1]; acc[2] += w * s0[2]; acc[3] += w * s0[3]; acc[4] += w * s1[0]; acc[5] += w * s1[1]; acc[6] += w * s1[2]; acc[7] += w * s1[3]; acc[8] += w * s2[0]; }
        __syncthreads();
        LAS f32x4* pr = (LAS f32x4*)(F.lds + RING_OFF);
#pragma unroll
        for (int ci = 0; ci < NCOND; ++ci) pr[(F.wave * NCOND + ci) * 64 + F.lane] = acc[ci];
        __syncthreads();
        for (int i = F.tid; i < NCOND * 64; i += NWAVES * 64) { const int ci = i >> 6, ln = i & 63; f32x4 s = pr[(0 * NCOND + ci) * 64 + ln];
#pragma unroll
            for (int w = 1; w < NWAVES; ++w) s += pr[(w * NCOND + ci) * 64 + ln];
            s += *(const f32x4*)(in[I_BMOD] + (size_t)l * NMODC + jj0 + ln * 4);
            *(f32x4*)((float*)(ws + WS_MOD) + (size_t)ci * pg8::MODROW + (size_t)l * NMODC + jj0 + ln * 4) = s; }
        __syncthreads();
    }
    { const int gt = (int)blockIdx.x * NWAVES * 64 + F.tid;
      if (gt < 1024) { const int pos = gt >> 4, f = gt & 15; const float inv = __builtin_amdgcn_exp2f(-(float)f * 0.8304820237218406f); float rev = (float)pos * inv * 0.15915494309189535f; rev -= floorf(rev);
          float* t = (float*)(ws + WS_ROPE) + gt * 2; t[0] = __builtin_amdgcn_cosf(rev); t[1] = __builtin_amdgcn_sinf(rev); } }
    for (int f = 0; f < 4; ++f) {
        tr_matrix8(F, in[I_W1] + (size_t)f * DM * DFF, DM, DFF, DFF, ws + WS_W13 + f * SZ_W13, DM, MAP_W1, pg8::W13_SCALE);
        tr_matrix8(F, in[I_W3] + (size_t)f * DM * DFF, DM, DFF, DFF, ws + WS_W13 + f * SZ_W13, DM, MAP_W3, pg8::W13_SCALE);
        tr_matrix8(F, in[I_W2] + (size_t)f * DFF * DM, DFF, DM, DM, ws + WS_W2 + f * SZ_W2, DFF, MAP_ID, pg8::W2_SCALE);
    }
    tr_matrix(F, in[I_WIN], DM, 4096, 4096, (bf16*)(ws + WS_WIN), DM, MAP_ID, 0);
    tr_matrix8(F, in[I_WIN], DM, 4096, 4096, ws + WS_WIN8, DM, MAP_ID, pg8::W13_SCALE);
    tr_matrix8(F, in[I_WMIXO], 1024, DM, DM, ws + WS_WMIX, DM, MAP_ID, pg8::W2_SCALE);
    tr_matrix(F, in[I_WDOWN], DM, 1088, 1088, (bf16*)(ws + WS_WDOWN), DM, MAP_DOWN, 0);
    tr_matrix8(F, in[I_WDOWN], DM, 1088, 1088, ws + WS_WDOWN8, DM, MAP_DOWN, pg8::W13_SCALE);
    tr_matrix8(F, in[I_WUQ], 512, 3072, 3072, ws + WS_WUQ, 512, MAP_UQ, 32.0f);
    tr_matrix8(F, in[I_WUKV], 512, 4096, 4096, ws + WS_WUKV, 512, MAP_ID, 32.0f);
    tr_matrix8(F, in[I_WOUT], DM, DM, DM, ws + WS_WOUT, DM, MAP_ID, pg8::W2_SCALE);
    { v4u* z = (v4u*)(ws + WS_WDOWN + (size_t)1088 * DM * 2); const int n16 = (NDOWN - 1088) * DM * 2 / 16;
      for (int i = (int)blockIdx.x * NWAVES * 64 + F.tid; i < n16; i += F.G * NWAVES * 64) z[i] = (v4u){0u, 0u, 0u, 0u};
      v4u* z8 = (v4u*)(ws + WS_WDOWN8 + (size_t)1088 * DM); const int m16 = (NDOWN - 1088) * DM / 16;
      for (int i = (int)blockIdx.x * NWAVES * 64 + F.tid; i < m16; i += F.G * NWAVES * 64) z8[i] = (v4u){0u, 0u, 0u, 0u}; }
    for (int item = (int)blockIdx.x; item < 512; item += F.G) {
        const int jb = item & 3, cb = (item >> 2) & 31, g = item >> 7, j = jb * 512 + F.tid, c0 = cb * 8;
        const float* wo = in[I_WMIXO] + (size_t)(1024 + g * 256) * DM + j; const float* ps = in[I_POOLS] + g * 256; const float* pw = in[I_POOLW] + ((size_t)g * 256 + c0) * 256;
        float a[8];
#pragma unroll
        for (int i = 0; i < 8; ++i) a[i] = 0.f;
#pragma unroll 4
        for (int d = 0; d < 256; ++d) { const float w = wo[(size_t)d * DM] * ps[d];
#pragma unroll
            for (int i = 0; i < 8; ++i) a[i] = fmaf(pw[i * 256 + d], w, a[i]); }
        v2u o; o.x = pg8::pk4_fp8(a[0] * pg8::W2_SCALE, a[1] * pg8::W2_SCALE, a[2] * pg8::W2_SCALE, a[3] * pg8::W2_SCALE); o.y = pg8::pk4_fp8(a[4] * pg8::W2_SCALE, a[5] * pg8::W2_SCALE, a[6] * pg8::W2_SCALE, a[7] * pg8::W2_SCALE);
        *(v2u*)(ws + WS_WMIX + (size_t)j * DM + 1024 + g * 256 + c0) = o;
    }
}
__device__ __forceinline__ void cast_na_cache(Frame& F) {
    KargTab in = F.in; unsigned char* ws = F.ws;
    const int n8 = MCACHE * 1024 / 8;
    for (int i = (int)blockIdx.x * NWAVES * 64 + F.tid; i < 2 * n8; i += F.G * NWAVES * 64) { const int which = i >= n8, e = (which ? i - n8 : i) * 8;
        const float* s = in[which ? I_CNV : I_CNK] + e; const f32x4 a = *(const f32x4*)s, b = *(const f32x4*)(s + 4);
        v4u o; o.x = pk2(a[0], a[1]); o.y = pk2(a[2], a[3]); o.z = pk2(b[0], b[1]); o.w = pk2(b[2], b[3]);
        *(v4u*)((bf16*)(ws + WS_EQ + (which ? 2 : 1) * SZ_QKVU) + (size_t)MTOK * 1024 + e) = o; }
}
__device__ __forceinline__ void p0b_modulate(Frame& F) {
    const float* modtab = (const float*)(F.ws + WS_MOD);
    { float* idln = (float*)(F.ws + WS_IDLN); const int gt = (int)blockIdx.x * NWAVES * 64 + F.tid; if (gt < 2 * DM) idln[gt] = gt < DM ? 1.0f : 0.0f; }
    { float* ab = (float*)(F.ws + WS_AB);
      for (int i = (int)blockIdx.x * NWAVES * 64 + F.tid; i < NCOND * 6 * DM; i += F.G * NWAVES * 64) { const int c = i % DM, q = (i / DM) % 6, ci = i / (6 * DM);
          const float g = F.in[I_LNG][q * DM + c], b = F.in[I_LNB][q * DM + c]; float A = g, B = b;
          if (q < 5) { const int qn = q + 1, ln = qn / 3, jn = qn % 3; const float* mt = modtab + (size_t)ci * pg8::MODROW + (size_t)(ln * 9 + 3 * jn) * DM; const float sh = mt[c], sc = mt[DM + c]; A = g * (1.0f + sc); B = b * (1.0f + sc) + sh; }
          ab[((size_t)(ci * 6 + q) * 2 + 0) * DM + c] = A; ab[((size_t)(ci * 6 + q) * 2 + 1) * DM + c] = B; } }
    for (int r = F.gw; r < MTOK; r += F.NGW) {
        const float* src = r < MCTX ? F.in[I_XP] + (size_t)r * DM : F.in[I_XS] + (size_t)(r - MCTX) * DM;
        const float* mt = modtab + (size_t)cond_of_row(r) * pg8::MODROW;
        unsigned char* ho = F.ws + WS_H + (size_t)r * DM;
        if (F.lane == 0) { typedef float f32x2_t __attribute__((ext_vector_type(2))); *(f32x2_t*)((float*)(F.ws + WS_ST) + 2 * (size_t)r) = (f32x2_t){1.0f, 0.0f}; }
#pragma unroll
        for (int j = 0; j < 8; ++j) { const int c = F.lane * 4 + 256 * j; const f32x4 v = *(const GAS f32x4*)(src + c), sh = *(const f32x4*)(mt + c), sc = *(const f32x4*)(mt + DM + c);
            const f32x4 h = v * (sc + 1.0f) + sh; *(GAS unsigned*)(ho + c) = pg8::pk4_fp8(h[0], h[1], h[2], h[3]);
            { typedef _Float16 h16x4 __attribute__((ext_vector_type(4))); *(GAS h16x4*)((bf16*)(F.ws + WS_T) + (size_t)r * DM + c) = __builtin_convertvector(v, h16x4); } }
    }
}
template <int OUT> __device__ __forceinline__ void ln_phase_t(Frame& F, int q, int r_begin, int r_end, int widx, int nw) {
    const float* ab = (const float*)(F.ws + WS_AB); float* ST = (float*)(F.ws + WS_ST); const bf16* T = (const bf16*)(F.ws + WS_T);
    v4u w[4], nxw[4];
#define LN_LOAD(dst, r) do { if ((r) < r_end) { const bf16* xr_ = T + (size_t)(r) * DM + F.lane * 8; _Pragma("unroll") for (int j = 0; j < 4; ++j) dst[j] = *(const GAS v4u*)(xr_ + 512 * j); } } while (0)
    int r = r_begin + widx; LN_LOAD(w, r);
    for (; r < r_end; r += nw) {
        const float* abr = ab + (size_t)(cond_of_row(r) * 6 + q) * 2 * DM + F.lane * 8;
        f32x4 A[8], B[8];
#pragma unroll
        for (int j = 0; j < 4; ++j) { A[2 * j] = *(const GAS f32x4*)(abr + 512 * j); A[2 * j + 1] = *(const GAS f32x4*)(abr + 512 * j + 4); B[2 * j] = *(const GAS f32x4*)(abr + DM + 512 * j); B[2 * j + 1] = *(const GAS f32x4*)(abr + DM + 512 * j + 4); }
        LN_LOAD(nxw, r + nw);
        f32x4 v[8]; float s = 0.f;
#pragma unroll
        for (int j = 0; j < 4; ++j) { const pg8::f32x8_t wf = __builtin_convertvector(__builtin_bit_cast(pg8::h16x8, w[j]), pg8::f32x8_t);
            v[2 * j] = (f32x4){wf[0], wf[1], wf[2], wf[3]}; v[2 * j + 1] = (f32x4){wf[4], wf[5], wf[6], wf[7]}; }
#pragma unroll
        for (int j = 0; j < 8; ++j) s += (v[j][0] + v[j][1]) + (v[j][2] + v[j][3]);
        const float mean = wave_sum(s) * (1.f / DM); float s2 = 0.f;
#pragma unroll
        for (int j = 0; j < 8; ++j) { v[j] = v[j] - mean; s2 += (v[j][0] * v[j][0] + v[j][1] * v[j][1]) + (v[j][2] * v[j][2] + v[j][3] * v[j][3]); }
        const float rstd = 1.f / sqrtf(wave_sum(s2) * (1.f / DM) + LN_EPS);
        if (OUT != 2 && F.lane == 0) { typedef float f32x2_t __attribute__((ext_vector_type(2))); *(f32x2_t*)(ST + 2 * (size_t)r) = (f32x2_t){rstd, -mean * rstd}; }
#pragma unroll
        for (int j = 0; j < 4; ++j) { const int c = F.lane * 8 + 512 * j; const f32x4 h0 = v[2 * j] * rstd * A[2 * j] + B[2 * j], h1 = v[2 * j + 1] * rstd * A[2 * j + 1] + B[2 * j + 1];
            if (OUT == 2) { *(GAS f32x4*)(F.out + (size_t)r * DM + c) = h0; *(GAS f32x4*)(F.out + (size_t)r * DM + c + 4) = h1; }
            else if (OUT == 0 || OUT == 3) { v2u o; o.x = pg8::pk4_fp8(h0[0], h0[1], h0[2], h0[3]); o.y = pg8::pk4_fp8(h1[0], h1[1], h1[2], h1[3]); *(GAS v2u*)(F.ws + WS_H + (size_t)r * DM + c) = o;
                if (OUT == 3 && r < MCTX) { v4u ob; ob.x = pk2(h0[0], h0[1]); ob.y = pk2(h0[2], h0[3]); ob.z = pk2(h1[0], h1[1]); ob.w = pk2(h1[2], h1[3]); *(GAS v4u*)((bf16*)(F.ws + WS_H + (size_t)MTOK * DM) + (size_t)r * DM + c) = ob; } }
            else { v4u o; o.x = pk2(h0[0], h0[1]); o.y = pk2(h0[2], h0[3]); o.z = pk2(h1[0], h1[1]); o.w = pk2(h1[2], h1[3]); *(GAS v4u*)((bf16*)(F.ws + WS_H) + (size_t)r * DM + c) = o; } }
#pragma unroll
        for (int j = 0; j < 4; ++j) w[j] = nxw[j];
    }
#undef LN_LOAD
}
template <int HW> __device__ __forceinline__ void pool_rows(const bf16* U, unsigned char* CAT, int r0, int s0, int L, int col) {
    float v0[32 + 2 * HW], v1[32 + 2 * HW];
#pragma unroll
    for (int i = 0; i < 32 + 2 * HW; ++i) { const int r = r0 - HW + i; unsigned w = 0u; if (r >= s0 && r < s0 + L) w = *(const unsigned*)(U + (size_t)r * 1024 + col);
        v0[i] = bf2f((unsigned short)(w & 0xffffu)); v1[i] = bf2f((unsigned short)(w >> 16)); }
    float a0 = 0.f, a1 = 0.f;
#pragma unroll
    for (int i = 0; i < 2 * HW; ++i) { a0 += v0[i]; a1 += v1[i]; }
#pragma unroll
    for (int i = 0; i < 32; ++i) { const int t = r0 + i - s0; int lo = t - HW, hi = t + HW; lo = lo < 0 ? 0 : lo; hi = hi > L ? L : hi; const float inv = 1.0f / (float)(hi - lo);
        *(unsigned short*)(CAT + (size_t)(r0 + i) * DM + 1024 + col) = (unsigned short)__builtin_amdgcn_cvt_pk_fp8_f32((a0 * inv - v0[i + HW]) * att::O_SCALE, (a1 * inv - v1[i + HW]) * att::O_SCALE, 0, false);
        if (i < 31) { a0 += v0[i + 2 * HW] - v0[i]; a1 += v1[i + 2 * HW] - v1[i]; } }
}
__device__ __forceinline__ void pool_item(Frame& F, int item) {
    const bf16* U = (const bf16*)(F.ws + WS_EQ + 3 * SZ_QKVU); unsigned char* CAT = F.ws + WS_CAT;
    const int r0 = item * 32, s0 = r0 < MCTX ? (r0 & ~255) : MCTX + ((r0 - MCTX) & ~4095), L = r0 < MCTX ? 256 : 4096;
    const int col = F.tid * 2, g = F.wave >> 1;
    if (g == 0) pool_rows<1>(U, CAT, r0, s0, L, col); else if (g == 1) pool_rows<2>(U, CAT, r0, s0, L, col); else if (g == 2) pool_rows<4>(U, CAT, r0, s0, L, col); else pool_rows<8>(U, CAT, r0, s0, L, col);
}
__device__ __forceinline__ void rms_phase(Frame& F) {
    const _Float16* DOWN = (const _Float16*)(F.ws + WS_DOWN); bf16* CQ = (bf16*)(F.ws + WS_CQ); bf16* CKV = (bf16*)(F.ws + WS_CKV); bf16* KPE = (bf16*)(F.ws + WS_KPE);
    const float* tab = (const float*)(F.ws + WS_ROPE);
    f32x4 qn[2], kn[2];
#pragma unroll
    for (int j = 0; j < 2; ++j) { qn[j] = *(const GAS f32x4*)(F.in[I_QNORM] + F.lane * 4 + 256 * j); kn[j] = *(const GAS f32x4*)(F.in[I_KVNORM] + F.lane * 4 + 256 * j); }
    const int p = F.lane, fidx = 4 * ((p & 31) >> 3) + (p & 3), porig = rope_orig(p);
    typedef _Float16 h4_ __attribute__((ext_vector_type(4)));
    h4_ ha[2], hb[2], nha[2], nhb[2]; _Float16 hk = (_Float16)0.f, nhk = (_Float16)0.f;
#define RMS_LOAD(A_, B_, K_, r) do { if ((r) < MTOK) { const _Float16* d_ = DOWN + (size_t)(r) * NDOWN; _Pragma("unroll") for (int j = 0; j < 2; ++j) { A_[j] = *(const GAS h4_*)(d_ + F.lane * 4 + 256 * j); B_[j] = *(const GAS h4_*)(d_ + 512 + F.lane * 4 + 256 * j); } K_ = d_[1024 + p]; } } while (0)
    int r = F.gw; RMS_LOAD(ha, hb, hk, r);
    for (; r < MTOK; r += F.NGW) {
        float cs = 1.f, sn = 0.f;
        if (r >= MCTX) { const int t = (r - MCTX) & 4095, pos = (p & 32) ? (t & 63) : (t >> 6); const float* tp = tab + (pos * 16 + fidx) * 2; cs = tp[0]; sn = tp[1]; }
        RMS_LOAD(nha, nhb, nhk, r + F.NGW);
        f32x4 a[2], b[2];
#pragma unroll
        for (int j = 0; j < 2; ++j) { a[j] = (f32x4){(float)ha[j][0], (float)ha[j][1], (float)ha[j][2], (float)ha[j][3]}; b[j] = (f32x4){(float)hb[j][0], (float)hb[j][1], (float)hb[j][2], (float)hb[j][3]}; }
        const float kv = (float)hk;
        float sa = 0.f, sb = 0.f;
#pragma unroll
        for (int j = 0; j < 2; ++j) { sa += (a[j][0] * a[j][0] + a[j][1] * a[j][1]) + (a[j][2] * a[j][2] + a[j][3] * a[j][3]); sb += (b[j][0] * b[j][0] + b[j][1] * b[j][1]) + (b[j][2] * b[j][2] + b[j][3] * b[j][3]); }
        const float ra = 1.f / sqrtf(wave_sum(sa) * (1.f / 512) + RMS_EPS), rb = 1.f / sqrtf(wave_sum(sb) * (1.f / 512) + RMS_EPS);
#pragma unroll
        for (int j = 0; j < 2; ++j) { const int c = F.lane * 4 + 256 * j; const f32x4 ya = a[j] * ra * qn[j], yb = b[j] * rb * kn[j];
            *(GAS unsigned*)((unsigned char*)CQ + (size_t)r * 512 + c) = pg8::pk4_fp8(ya[0], ya[1], ya[2], ya[3]);
            *(GAS unsigned*)((unsigned char*)CKV + (size_t)r * 512 + c) = pg8::pk4_fp8(yb[0], yb[1], yb[2], yb[3]);
            if (r < MCTX) *(GAS f32x4*)(F.out + OUT_CKV + (size_t)r * 512 + c) = yb; }
        const float pv = shfl_xor_c<4>(kv);
        const float o = (p & 4) ? (kv * cs + pv * sn) : (kv * cs - pv * sn);
        if (r < MCTX) F.out[OUT_KPE + (size_t)r * 64 + porig] = kv;
        ((unsigned char*)KPE)[(size_t)r * 64 + p] = (unsigned char)(__builtin_amdgcn_cvt_pk_fp8_f32(o, o, 0, false) & 0xff);
#pragma unroll
        for (int j = 0; j < 2; ++j) { ha[j] = nha[j]; hb[j] = nhb[j]; }
        hk = nhk;
    }
#undef RMS_LOAD
    for (int i = F.gw; i < MCACHE; i += F.NGW) { const int rr = MTOK + i; const float* ck = F.in[I_CCKV] + (size_t)i * 512;
        const f32x4 y0 = *(const GAS f32x4*)(ck + F.lane * 4), y1 = *(const GAS f32x4*)(ck + F.lane * 4 + 256); const float kp = F.in[I_CKPE][(size_t)i * 64 + porig];
        *(GAS unsigned*)((unsigned char*)CKV + (size_t)rr * 512 + F.lane * 4) = pg8::pk4_fp8(y0[0], y0[1], y0[2], y0[3]);
        *(GAS unsigned*)((unsigned char*)CKV + (size_t)rr * 512 + F.lane * 4 + 256) = pg8::pk4_fp8(y1[0], y1[1], y1[2], y1[3]);
        ((unsigned char*)KPE)[(size_t)rr * 64 + p] = (unsigned char)(__builtin_amdgcn_cvt_pk_fp8_f32(kp, kp, 0, false) & 0xff); }
}
__device__ __forceinline__ void even_attn_phase(Frame& F, LAS unsigned char* lds_att) {
    const bf16* Q = (const bf16*)(F.ws + WS_EQ); const bf16* K = (const bf16*)(F.ws + WS_EQ + SZ_QKVU); const bf16* V = (const bf16*)(F.ws + WS_EQ + 2 * SZ_QKVU); unsigned char* CAT = F.ws + WS_CAT;
    for (int u = F.vcu; u < 1152; u += F.G) {
        att::UnitArgs A; A.KR = nullptr; A.C = 0.08838834764831845f * 1.4426950408889634f; A.seg0_tiles = 4;
        int row0, h;
        if (u < 1024) { const int qb = u & 15, b = u >> 7; h = (u >> 4) & 7; row0 = MCTX + b * 4096 + qb * 256;
            const int r0 = 4 * qb; const int lo = qb == 0 ? 0 : (qb == 15 ? 56 : (r0 - 4 < 52 ? r0 - 4 : 52)); const int nloc = (qb == 0 || qb == 15) ? 8 : 12;
            A.NT = 4 + nloc; A.seg0_row = MTOK + b * 256; A.seg1_row = MCTX + b * 4096 + lo * 64; A.rpb = F.in[I_RPB] + h * 465; A.lo_row = lo; A.r0 = r0; }
        else { const int v = u - 1024, b = v >> 3; h = v & 7; row0 = b * 256; A.NT = 4; A.seg0_row = row0; A.seg1_row = 0; A.rpb = nullptr; A.lo_row = 0; A.r0 = 0; }
        A.Q = Q + (size_t)row0 * 1024 + h * 128; A.K = K + h * 128; A.V = V + h * 128; A.O = CAT + (size_t)row0 * DM + h * 128;
        att::attn_unit<1>(A, lds_att, F.wid0);
    }
    for (int u = F.vcu; u < 1152; u += F.G) pool_item(F, u);
    { const int n8 = MCTX * 1024 / 8;
      for (int i = (int)blockIdx.x * NWAVES * 64 + F.tid; i < 2 * n8; i += F.G * NWAVES * 64) { const int which = i >= n8, e = (which ? i - n8 : i) * 8;
          const v4u w = *(const v4u*)((which ? V : K) + e); float* o = F.out + (which ? OUT_NAV : OUT_NAK) + e;
          *(f32x4*)o = (f32x4){bf2f((unsigned short)(w.x & 0xffffu)), bf2f((unsigned short)(w.x >> 16)), bf2f((unsigned short)(w.y & 0xffffu)), bf2f((unsigned short)(w.y >> 16))};
          *(f32x4*)(o + 4) = (f32x4){bf2f((unsigned short)(w.z & 0xffffu)), bf2f((unsigned short)(w.z >> 16)), bf2f((unsigned short)(w.w & 0xffffu)), bf2f((unsigned short)(w.w >> 16))}; } }
}
template <int VAR = 0> __device__ __forceinline__ void odd_attn_phase(Frame& F, LAS unsigned char* lds_att) {
    const unsigned char* Q8 = F.ws + WS_MQ; const unsigned char* K8 = F.ws + WS_KV; const unsigned char* VT8 = F.ws + WS_KV + (size_t)MKV * 2048; const unsigned char* KPE8 = F.ws + WS_KPE; unsigned char* O = F.ws + WS_H;
    for (int u = F.vcu; u < 2304; u += F.G) {
        att::UnitArgs A; A.KR = (const bf16*)KPE8; A.C = 0.07216878364870322f * 1.4426950408889634f; A.rpb = nullptr; A.lo_row = 0; A.r0 = 0;
        int row0, h;
        if (u < 2048) { const int qb = u & 15; h = (u >> 4) & 15; const int b = u >> 8; row0 = MCTX + b * 4096 + qb * 256;
            A.NT = 68; A.seg0_tiles = 64; A.seg0_row = MCTX + b * 4096; A.seg1_row = MTOK + b * 256; }
        else { const int v = u - 2048; h = v & 15; const int b = v >> 4; row0 = b * 256; A.NT = 4; A.seg0_tiles = 4; A.seg0_row = row0; A.seg1_row = 0; }
        A.Q = (const bf16*)(Q8 + (size_t)row0 * 3072 + h * 192); A.K = (const bf16*)(K8 + h * 128); A.V = (const bf16*)(VT8 + (size_t)h * 128 * MKV); A.O = O + (size_t)row0 * DM + h * 128;
        att::attn_unit<2, VAR>(A, lds_att, F.wid0);
    }
}

#define RESID_SEQ(MASKID, GEMM_INIT, EPI_INIT, RB_ROWS, LN_DISPATCH, EXTRA_C) \
    for (int part = 0; part < 3; ++part) { PH_BEGIN(MASKID) \
        const int n_units = (MTOK / 256) * 8, full = (n_units / F.G) * F.G, left = n_units - full; \
        if (part < 2) { pg8::Gemm g GEMM_INIT; pg8::PanelOrder S{part ? full : 0, part ? n_units : full, 8, F.G, F.vcu}; pg8::EpiResid E EPI_INIT; \
            pg8::gemm_phase<pg8::EpiResid, pg8::PanelOrder, true, true, true>(ring, g, S, E, wid0); \
            F.lane = hw_lane(); F.tid = F.wave * 64 + F.lane; }     \
        if (part == 2 || (part == 1 && F.vcu >= left)) { const int rb_ = (RB_ROWS); \
            const int r0_ = part == 1 ? 0 : rb_, r1_ = part == 1 ? rb_ : MTOK, wi_ = part == 1 ? (F.vcu - left) * NWAVES + F.wave : F.gw, nw_ = part == 1 ? (F.G - left) * NWAVES : F.NGW; \
            LN_DISPATCH(r0_, r1_, wi_, nw_) } \
        if (part == 2) { EXTRA_C } \
    PH_END }

__device__ __forceinline__ unsigned long long launder_u64(unsigned long long p) { asm volatile("" : "+s"(p)); return p; }
__device__ __forceinline__ void frame_init(Frame& F, LAS unsigned char* lds, const int wid0) {
    int wid_ = wid0; asm volatile("" : "+s"(wid_));
    const int lane = hw_lane(), tid = wid_ * 64 + lane;
    F.lds = lds; F.MISC = (volatile LAS unsigned*)(lds + MISC_OFF);
    F.tid = tid; F.lane = lane; F.wave = wid_; F.wid0 = wid0;
    F.G = gridDim.x; { const int bx = blockIdx.x; F.vcu = (F.G % 8 == 0) ? (bx % 8) * (F.G / 8) + bx / 8 : bx; }
    F.gw = F.vcu * NWAVES + F.wave; F.NGW = F.G * NWAVES;
    CAS const unsigned char* kp = (CAS const unsigned char*)launder_u64((unsigned long long)__builtin_amdgcn_kernarg_segment_ptr());
    F.in = (KargTab)kp; { typedef float* FP_; typedef unsigned char* UP_; F.out = *(CAS const FP_*)(kp + N_IN * 8); F.ws = *(CAS const UP_*)(kp + N_IN * 8 + 8); } F.ctl = (unsigned*)(F.ws + WS_CTL); F.probe = *(CAS const int*)(kp + N_IN * 8 + 28);
}
static_assert(sizeof(Args) == N_IN * 8 + 32, "Args layout");
static_assert(att::VT_PITCH == MKV, "transposed-V row pitch");
__global__ void __launch_bounds__(NWAVES * 64, 2) fwd_kernel(Args args) {
    extern __shared__ __attribute__((aligned(16))) unsigned char lds_raw[];
    LAS unsigned char* const ldsb = (LAS unsigned char*)lds_raw;
    const int wid0 = __builtin_amdgcn_readfirstlane((int)threadIdx.x >> 6);
    for (int u = threadIdx.x; u < (LDS_BYTES - LDSCTL_OFF) / 4; u += NWAVES * 64) ((LAS unsigned*)(ldsb + LDSCTL_OFF))[u] = 0u;
    __syncthreads();
    XcdBarrier bar = xcd_barrier_post((unsigned*)(args.ws + WS_CTL) + CW_BAR + args.li * XCD_BAR_WORDS, (volatile LAS unsigned*)(ldsb + MISC_OFF) + 8, wid0);
    const int lo = args.ph_lo, hi = args.ph_hi; int ph = 0;
#ifndef PHASE_MASK
#define PHASE_MASK 0xFFFF
#endif
#define PHON(k) (((PHASE_MASK) >> (k)) & 1)
#define PH_BEGIN(k) if (PHON(k) && lo <= ph && ph < hi) { asm volatile("; PHASE_MARK " #k ::: "memory"); Frame F; frame_init(F, ldsb, wid0); \
    unsigned char* const ws = F.ws; LAS unsigned char* const ring = F.lds + RING_OFF; const float* const modtab = (const float*)(ws + WS_MOD); (void)ring; (void)modtab;
#define PH_END   if (ph + 1 < hi) { xcd_barrier(bar); if ((F.probe >> 9) & 1) xcd_barrier(bar); } } ++ph;

    PH_BEGIN(0) for (int rep = 0; rep < 1 + ((F.probe >> 2) & 1); ++rep) p0_prologue(F); PH_END
    PH_BEGIN(1) for (int rep = 0; rep < 1 + ((F.probe >> 7) & 1); ++rep) p0b_modulate(F); PH_END
#pragma unroll 1
    for (int f = 0; f < 4; ++f) {
        const int l = f >> 1, slot = f & 1, jsub = slot ? 2 : 0;
        PH_BEGIN(2)
            pg8::Gemm g{(const pg8::bf16_t*)(ws + WS_H), (const pg8::bf16_t*)(ws + WS_W13 + f * SZ_W13), MTOK, 2 * DFF, DM / 2};
            pg8::EpiSwiGLU E{ws + WS_G, DFF};
            pg8::ColBlockOrder S; S.init(MTOK, 2 * DFF, F.G, F.vcu);
            for (int rep = 0; rep < 1 + (F.probe & 1); ++rep)
            pg8::gemm_phase<pg8::EpiSwiGLU, pg8::ColBlockOrder, true, true, true>(ring, g, S, E, wid0);
        PH_END
        {
            const int qp = l * 3 + jsub - 1, q = l * 3 + jsub; const bool first = qp < 0;
            const unsigned long long fm = 0ull - (unsigned long long)first;
#define BLEND_PTR(a, b) ((const float*)(((unsigned long long)(a) & fm) | ((unsigned long long)(b) & ~fm)))
#define LN_FFN(r0, r1, wi, nw) { if (slot == 0) { ln_phase_t<3>(F, q, r0, r1, wi, nw); } else if (q < 5) ln_phase_t<0>(F, q, r0, r1, wi, nw); else ln_phase_t<2>(F, q, r0, r1, wi, nw); }
            RESID_SEQ(3, ({(const pg8::bf16_t*)(ws + WS_G), (const pg8::bf16_t*)(ws + WS_W2 + f * SZ_W2), MTOK, DM, DFF / 2}),
                      ({(pg8::bf16_t*)(ws + WS_T), modtab + (size_t)(l * 9 + 3 * jsub + 2) * DM, (const float*)(ws + WS_ST), BLEND_PTR(ws + WS_IDLN, F.in[I_LNG] + (size_t)(first ? 0 : qp) * DM), BLEND_PTR((const float*)(ws + WS_IDLN) + DM, F.in[I_LNB] + (size_t)(first ? 0 : qp) * DM), 0.5 / pg8::W2_SCALE}),
                      112 * 256, LN_FFN, if (f == 0) cast_na_cache(F);)
#undef LN_FFN
#undef BLEND_PTR
        }
        if (f == 0) {
            PH_BEGIN(5)
                { pg8::Gemm g{(const pg8::bf16_t*)(ws + WS_H), (const pg8::bf16_t*)(ws + WS_WIN8), MTOK, 4096, DM / 2}; pg8::ColBlockOrder S; S.init(MTOK, 4096, F.G, F.vcu);
                  pg8::EpiBf16 E{(pg8::bf16_t*)(ws + WS_EQ), 1024, 1024, SZ_QKVU / 2, 1.0 / pg8::W13_SCALE, 16};
                  for (int rep = 0; rep < 1 + ((F.probe >> 4) & 1); ++rep)
                  pg8::gemm_phase<pg8::EpiBf16, pg8::ColBlockOrder, true, true, true>(ring, g, S, E, wid0); }
                __syncthreads();
                { pg8::Gemm g{(const pg8::bf16_t*)(ws + WS_H + (size_t)MTOK * DM), (const pg8::bf16_t*)(ws + WS_WIN + (size_t)1024 * DM * 2), MCTX, 2048, DM}; pg8::StaticOrder S; S.init(MCTX, 2048, F.G, (int)blockIdx.x);
                  pg8::EpiBf16 E{(pg8::bf16_t*)(ws + WS_EQ + SZ_QKVU), 1024, 1024, SZ_QKVU / 2, 1.0, 0};
                  pg8::gemm_phase<pg8::EpiBf16, pg8::StaticOrder, true, true>(ring, g, S, E, wid0); }
            PH_END
            PH_BEGIN(6) for (int rep = 0; rep < 1 + ((F.probe >> 3) & 1); ++rep) even_attn_phase(F, ring); PH_END
#define LN_MIX0(r0, r1, wi, nw) { ln_phase_t<0>(F, 0 * 3 + 1, r0, r1, wi, nw); }
            RESID_SEQ(7, ({(const pg8::bf16_t*)(ws + WS_CAT), (const pg8::bf16_t*)(ws + WS_WMIX), MTOK, DM, DM / 2}),
                      ({(pg8::bf16_t*)(ws + WS_T), modtab + (size_t)(0 * 9 + 3 * 1 + 2) * DM, (const float*)(ws + WS_ST), F.in[I_LNG] + (size_t)0 * DM, F.in[I_LNB] + (size_t)0 * DM, 1.0 / (pg8::W2_SCALE * att::O_SCALE)}),
                      40 * 256, LN_MIX0, )
#undef LN_MIX0
        }
        if (f == 2) {
            PH_BEGIN(8)
                { pg8::Gemm g{(const pg8::bf16_t*)(ws + WS_H + (size_t)MTOK * DM), (const pg8::bf16_t*)(ws + WS_WDOWN + (size_t)512 * DM * 2), MCTX, 768, DM}; pg8::PanelOrder S{0, 48, 3, F.G, F.vcu};
                  pg8::EpiF16 E{(pg8::bf16_t*)(ws + WS_DOWN) + 512, NDOWN, 1.0};
                  pg8::gemm_phase<pg8::EpiF16, pg8::PanelOrder, true, true>(ring, g, S, E, wid0); }
                __syncthreads();
                { pg8::Gemm g{(const pg8::bf16_t*)(ws + WS_H), (const pg8::bf16_t*)(ws + WS_WDOWN8), MTOK, NDOWN, DM / 2}; pg8::DownOrder S{F.G, F.vcu};
                  pg8::EpiF16 E{(pg8::bf16_t*)(ws + WS_DOWN), NDOWN, 1.0 / pg8::W13_SCALE};
                  for (int rep = 0; rep < 1 + ((F.probe >> 5) & 1); ++rep)
                  pg8::gemm_phase<pg8::EpiF16, pg8::DownOrder, true, true, true>(ring, g, S, E, wid0); }
            PH_END
            PH_BEGIN(9) for (int rep = 0; rep < 1 + ((F.probe >> 7) & 1); ++rep) rms_phase(F); PH_END
            PH_BEGIN(10)
#if !defined(G67_ONLY) || G67_ONLY == 1
                { pg8::Gemm g{(const pg8::bf16_t*)(ws + WS_CKV), (const pg8::bf16_t*)(ws + WS_WUKV), MKV, 4096, 256}; pg8::ColBlockOrder S; S.init(MKV, 4096, F.G, F.vcu);
                  pg8::EpiKV8 E{ws + WS_KV, ws + WS_KV + (size_t)MKV * 2048, 1.0 / 32.0};
                  for (int rep = 0; rep < 1 + (((F.probe >> 5) | (F.probe >> 10)) & 1); ++rep)
                  pg8::gemm_phase<pg8::EpiKV8, pg8::ColBlockOrder, true, true, true>(ring, g, S, E, wid0); }
#endif
                __syncthreads();
#if !defined(G67_ONLY) || G67_ONLY == 2
                { pg8::Gemm g{(const pg8::bf16_t*)(ws + WS_CQ), (const pg8::bf16_t*)(ws + WS_WUQ), MTOK, 3072, 256}; pg8::ColBlockOrder S; S.init(MTOK, 3072, F.G, F.vcu);
                  { LAS float* tl = (LAS float*)(F.lds + MISC_OFF + 1024); const float* tg = (const float*)(ws + WS_ROPE);
                    for (int i = F.wave * 64 + hw_lane(); i < 2048; i += NWAVES * 64) tl[i] = tg[i]; }
                  __syncthreads();
                  pg8::EpiQRope E{ws + WS_MQ, (long)(unsigned)(uintptr_t)(F.lds + MISC_OFF + 1024)};
                  for (int rep = 0; rep < 1 + (((F.probe >> 5) | (F.probe >> 11)) & 1); ++rep)
                  pg8::gemm_phase<pg8::EpiQRope, pg8::ColBlockOrder, true, true, true>(ring, g, S, E, wid0); }
#endif
            PH_END
#ifdef MK_VAR
            PH_BEGIN(11) odd_attn_phase<MK_VAR>(F, ring); for (int rep = 0; rep < 1 + ((F.probe >> 1) & 1); ++rep) odd_attn_phase(F, ring); PH_END
#else
            PH_BEGIN(11) for (int rep = 0; rep < 1 + ((F.probe >> 1) & 1); ++rep) odd_attn_phase(F, ring); PH_END
#endif
#define LN_MIX1(r0, r1, wi, nw) { ln_phase_t<0>(F, 1 * 3 + 1, r0, r1, wi, nw); }
            RESID_SEQ(12, ({(const pg8::bf16_t*)(ws + WS_H), (const pg8::bf16_t*)(ws + WS_WOUT), MTOK, DM, DM / 2}),
                      ({(pg8::bf16_t*)(ws + WS_T), modtab + (size_t)(1 * 9 + 3 * 1 + 2) * DM, (const float*)(ws + WS_ST), F.in[I_LNG] + (size_t)3 * DM, F.in[I_LNB] + (size_t)3 * DM, 1.0 / (pg8::W2_SCALE * att::O_SCALE)}),
                      40 * 256, LN_MIX1, )
#undef LN_MIX1
        }
    }
#undef PH_BEGIN
#undef PH_END
}
constexpr int N_PHASES = 2 + 4 * 4 + 5 + 7;

#ifndef MK_PER_PHASE
#define MK_PER_PHASE 0
#endif
extern "C" void kernel_launch(void* const* d_in, const int* in_sizes, int n_in, void* d_out, int out_size, void* d_ws, size_t ws_size, hipStream_t stream) {
    static int grid = 0;
    if (grid == 0) {
        if (n_in != N_IN || out_size != (int)OUT_END) fprintf(stderr, "kernel_launch: warning: n_in %d (expect %d) out %d (expect %zu)\n", n_in, (int)N_IN, out_size, (size_t)OUT_END);
        if (ws_size < WS_END) { fprintf(stderr, "kernel_launch: workspace too small: %zu < %zu\n", ws_size, (size_t)WS_END); grid = -1; return; }
        int dev = 0, cus = 0, per_cu = 0;
        if (hipGetDevice(&dev) != hipSuccess || hipDeviceGetAttribute(&cus, hipDeviceAttributeMultiprocessorCount, dev) != hipSuccess) { grid = -1; return; }
        if (hipFuncSetAttribute((const void*)fwd_kernel, hipFuncAttributeMaxDynamicSharedMemorySize, LDS_BYTES) != hipSuccess) { fprintf(stderr, "kernel_launch: hipFuncSetAttribute failed\n"); grid = -1; return; }
        if (hipOccupancyMaxActiveBlocksPerMultiprocessor(&per_cu, (const void*)fwd_kernel, NWAVES * 64, LDS_BYTES) != hipSuccess || per_cu < 1) fprintf(stderr, "kernel_launch: occupancy query reports %d\n", per_cu);
        (void)hipGetLastError();
        grid = cus;
    }
    if (grid < 0) return;
    if (hipMemsetAsync((char*)d_ws + WS_CTL, 0, CTL_ZERO_BYTES, stream) != hipSuccess) return;
    Args a{};
    for (int i = 0; i < N_IN; ++i) a.in[i] = (const float*)d_in[i];
    a.out = (float*)d_out; a.ws = (unsigned char*)d_ws;
#ifndef MK_PROBE
#define MK_PROBE 0
#endif
    a.pad = MK_PROBE;
#if MK_PER_PHASE
    for (int p = 0; p < N_PHASES; ++p) { a.ph_lo = p; a.ph_hi = p + 1; a.li = p;
        hipLaunchKernelGGL(fwd_kernel, dim3(grid), dim3(NWAVES * 64), LDS_BYTES, stream, a); }
#else
    a.ph_lo = 0; a.ph_hi = N_PHASES; a.li = 0;
    hipLaunchKernelGGL(fwd_kernel, dim3(grid), dim3(NWAVES * 64), LDS_BYTES, stream, a);
#endif
    const hipError_t le = hipPeekAtLastError();
    if (le != hipSuccess) fprintf(stderr, "kernel_launch: launch failed: %s\n", hipGetErrorName(le));
}
```
